# Optimizing an MI355X kernel written in HIP

```python
import jax, jax.numpy as jnp
from jax import lax
import numpy as np

D_MODEL = 2048
BATCH = 4
SEQ = 4096
DEPTH = 2

N_A_LAYERS = DEPTH // 2
N_B_LAYERS = DEPTH - N_A_LAYERS
N_DENSE_LAYERS = (DEPTH + 1) // 2
N_MOE_LAYERS = DEPTH // 2

GLA_HEADS = 4
GLA_DK = D_MODEL // 2
GLA_DV = D_MODEL
GLA_DK_HEAD = GLA_DK // GLA_HEADS
GLA_DV_HEAD = GLA_DV // GLA_HEADS
GLA_GATE_RANK = 16
GLA_TAU = 16.0
GLA_CHUNK = 64

MOBA_HEADS = 16
MOBA_KV_HEADS = 4
MOBA_HEAD_DIM = D_MODEL // MOBA_HEADS
MOBA_BLOCK = 256
MOBA_TOPK = 3
MOBA_QGROUP = 128
MOBA_GROUPS_PER_STEP = 32

FFN_DENSE = 5504
N_EXPERTS = 8
TOP_K = 2
FFN_EXPERT = 7168
MOE_GROUP = 1024

LN_EPS = 1e-5
RMS_EPS = 1e-6
DEEPNORM_ALPHA = (2 * DEPTH) ** 0.25
DEEPNORM_BETA = (8 * DEPTH) ** -0.25

kernel_name = "yoco_gla_moba_moe_deepnorm"

F32 = jnp.float32


def layer_norm(x, g, b):
    xf = x.astype(F32)
    mu = jnp.mean(xf, -1, keepdims=True)
    var = jnp.mean(jnp.square(xf - mu), -1, keepdims=True)
    return ((xf - mu) * lax.rsqrt(var + LN_EPS) * g + b).astype(x.dtype)


def post_norm(x, y, g, b):
    return layer_norm(DEEPNORM_ALPHA * x + y, g, b)


def group_rows(seg, num_segments, group, multiple):
    n_asg = seg.shape[0]
    cap = -(-(n_asg + num_segments * group) // multiple) * multiple
    counts = jax.ops.segment_sum(jnp.ones_like(seg), seg, num_segments=num_segments)
    padded = (counts + group - 1) // group * group
    pad_end = jnp.cumsum(padded)
    pad_start = pad_end - padded
    start = jnp.cumsum(counts) - counts
    order = jnp.argsort(seg)
    sorted_seg = seg[order]
    dest_sorted = pad_start[sorted_seg] + jnp.arange(n_asg, dtype=seg.dtype) - start[sorted_seg]
    dest = jnp.zeros_like(seg).at[order].set(dest_sorted)
    group_start = jnp.arange(cap // group, dtype=seg.dtype) * group
    group_seg = jnp.minimum(jnp.searchsorted(pad_end, group_start, side="right"), num_segments - 1)
    group_used = group_start < pad_end[-1]
    return dest, group_seg, group_used, cap


def gla_mixer(h, w_in, w_gate_up, b_gate, g_norm, w_o):
    bsz, s, _ = h.shape
    n_chunk = -(-s // GLA_CHUNK)
    pad = n_chunk * GLA_CHUNK - s
    proj = h @ w_in
    q, k, v, r, z = jnp.split(
        proj, [GLA_DK, 2 * GLA_DK, 2 * GLA_DK + GLA_DV, 2 * GLA_DK + 2 * GLA_DV], axis=-1)
    log_a = jax.nn.log_sigmoid((z @ w_gate_up + b_gate).astype(F32)) / GLA_TAU

    def chunked(t, hd):
        t = jnp.pad(t.astype(F32), ((0, 0), (0, pad), (0, 0)))
        return t.reshape(bsz, n_chunk, GLA_CHUNK, GLA_HEADS, hd)

    q_c = chunked(q, GLA_DK_HEAD) * (GLA_DK_HEAD ** -0.5)
    k_c = chunked(k, GLA_DK_HEAD)
    v_c = chunked(v, GLA_DV_HEAD)
    b_cum = jnp.cumsum(chunked(log_a, GLA_DK_HEAD), axis=2)
    b_last = b_cum[:, :, -1:]
    q_dec = q_c * jnp.exp(b_cum)
    k_inv = k_c * jnp.exp(-b_cum)
    k_end = k_c * jnp.exp(b_last - b_cum)
    causal = jnp.tril(jnp.ones((GLA_CHUNK, GLA_CHUNK), bool))
    att = jnp.einsum("bncht,bnmht->bnhcm", q_dec, k_inv)
    att = jnp.where(causal, att, 0.0)
    o_intra = jnp.einsum("bnhcm,bnmhv->bnchv", att, v_c)
    decay = jnp.exp(b_last[:, :, 0])

    def scan_step(state, xs):
        q_n, k_n, v_n, d_n = xs
        o_n = jnp.einsum("bcht,bhtv->bchv", q_n, state)
        state = d_n[..., None] * state + jnp.einsum("bcht,bchv->bhtv", k_n, v_n)
        return state, o_n

    mv = lambda t: jnp.moveaxis(t, 1, 0)
    state0 = jnp.zeros((bsz, GLA_HEADS, GLA_DK_HEAD, GLA_DV_HEAD), F32)
    _, o_inter = lax.scan(scan_step, state0, (mv(q_dec), mv(k_end), mv(v_c), mv(decay)))
    o = (o_intra + jnp.moveaxis(o_inter, 0, 1)).reshape(bsz, n_chunk * GLA_CHUNK, GLA_HEADS, GLA_DV_HEAD)[:, :s]
    o = o * lax.rsqrt(jnp.mean(o * o, -1, keepdims=True) + RMS_EPS) * g_norm
    o = (o.reshape(bsz, s, GLA_DV) * jax.nn.silu(r.astype(F32))).astype(h.dtype)
    return o @ w_o


def moba_shared_kv(h, w_kv):
    bsz, s, _ = h.shape
    n_blk = -(-s // MOBA_BLOCK)
    pad = n_blk * MOBA_BLOCK - s
    kv = jnp.pad(h @ w_kv, ((0, 0), (0, pad), (0, 0)))
    kv = kv.reshape(bsz, n_blk, MOBA_BLOCK, 2, MOBA_KV_HEADS, MOBA_HEAD_DIM)
    k_blk = kv[:, :, :, 0].transpose(0, 3, 1, 2, 4)
    v_blk = kv[:, :, :, 1].transpose(0, 3, 1, 2, 4)
    count = jnp.clip(s - jnp.arange(n_blk) * MOBA_BLOCK, 1, MOBA_BLOCK).astype(F32)
    k_mean = k_blk.astype(F32).sum(3) / count[None, None, :, None]
    return k_blk, v_blk, k_mean


def grouped_block_attention(q_rows, k_seg, v_seg, group_seg, group_used):
    cap, hd = q_rows.shape
    n_steps = cap // (MOBA_QGROUP * MOBA_GROUPS_PER_STEP)
    qs = q_rows.reshape(n_steps, MOBA_GROUPS_PER_STEP, MOBA_QGROUP, hd)
    segs = group_seg.reshape(n_steps, MOBA_GROUPS_PER_STEP)
    used = group_used.reshape(n_steps, MOBA_GROUPS_PER_STEP)

    def step(args):
        qg, sg, ug = args

        def compute():
            kg = k_seg[sg].astype(F32)
            vg = v_seg[sg].astype(F32)
            sc = jnp.einsum("pqd,pkd->pqk", qg.astype(F32), kg)
            m = sc.max(-1)
            p = jnp.exp(sc - m[..., None])
            return jnp.einsum("pqk,pkd->pqd", p, vg), m, p.sum(-1)

        def skip():
            zr = jnp.zeros(qg.shape[:-1], F32)
            return jnp.zeros(qg.shape, F32), zr, zr

        return lax.cond(jnp.any(ug), compute, skip)

    o, m, l = lax.map(step, (qs, segs, used))
    return o.reshape(cap, hd), m.reshape(cap), l.reshape(cap)


def moba_mixer(h, w_q, w_o, k_blk, v_blk, k_mean):
    bsz, s, _ = h.shape
    n_blk = k_blk.shape[2]
    s_pad = n_blk * MOBA_BLOCK
    rep = MOBA_HEADS // MOBA_KV_HEADS
    hd = MOBA_HEAD_DIM
    q = (h @ w_q).reshape(bsz, s, MOBA_KV_HEADS, rep, hd) * (hd ** -0.5)

    gate = jnp.einsum("bsgrd,bgnd->bsgrn", q.astype(F32), k_mean)
    q_blk = jnp.arange(s) // MOBA_BLOCK
    past = jnp.arange(n_blk)[None, :] < q_blk[:, None]
    gate = jnp.where(past[None, :, None, None, :], gate, -jnp.inf)
    top_k = min(MOBA_TOPK, n_blk)
    _, sel = lax.top_k(gate, top_k)
    valid = sel < q_blk[None, :, None, None, None]

    q_pad = jnp.pad(q, ((0, 0), (0, s_pad - s), (0, 0), (0, 0), (0, 0)))
    q_pad = q_pad.reshape(bsz, n_blk, MOBA_BLOCK, MOBA_KV_HEADS, rep, hd)
    s_own = jnp.einsum("bnqgrd,bgnkd->bnqgrk", q_pad.astype(F32), k_blk.astype(F32))
    causal = jnp.tril(jnp.ones((MOBA_BLOCK, MOBA_BLOCK), bool))
    s_own = jnp.where(causal[None, None, :, None, None, :], s_own, -jnp.inf)
    m_own = s_own.max(-1)
    p_own = jnp.exp(s_own - m_own[..., None])
    l_own = p_own.sum(-1).reshape(bsz, s_pad, MOBA_KV_HEADS, rep)[:, :s]
    o_own = jnp.einsum("bnqgrk,bgnkd->bnqgrd", p_own, v_blk.astype(F32))
    o_own = o_own.reshape(bsz, s_pad, MOBA_KV_HEADS, rep, hd)[:, :s]
    m_own = m_own.reshape(bsz, s_pad, MOBA_KV_HEADS, rep)[:, :s]

    n_seg = bsz * MOBA_KV_HEADS * n_blk
    b_idx = jnp.arange(bsz)[:, None, None, None, None]
    g_idx = jnp.arange(MOBA_KV_HEADS)[None, None, :, None, None]
    seg = ((b_idx * MOBA_KV_HEADS + g_idx) * n_blk + sel).reshape(-1).astype(jnp.int32)
    dest, group_seg, group_used, cap = group_rows(
        seg, n_seg, MOBA_QGROUP, MOBA_QGROUP * MOBA_GROUPS_PER_STEP)
    q_rows = jnp.zeros((cap, hd), q.dtype).at[dest].set(jnp.repeat(q.reshape(-1, hd), top_k, axis=0))
    k_seg = k_blk.reshape(n_seg, MOBA_BLOCK, hd)
    v_seg = v_blk.reshape(n_seg, MOBA_BLOCK, hd)
    o_rows, m_rows, l_rows = grouped_block_attention(q_rows, k_seg, v_seg, group_seg, group_used)
    sel_shape = (bsz, s, MOBA_KV_HEADS, rep, top_k)
    o_sel = o_rows[dest].reshape(sel_shape + (hd,))
    m_sel = jnp.where(valid, m_rows[dest].reshape(sel_shape), -jnp.inf)
    l_sel = l_rows[dest].reshape(sel_shape)

    m_tot = jnp.maximum(m_own, m_sel.max(-1))
    w_own = jnp.exp(m_own - m_tot)
    w_sel = jnp.exp(m_sel - m_tot[..., None])
    num = o_own * w_own[..., None] + jnp.einsum("bsgrt,bsgrtd->bsgrd", w_sel, o_sel)
    den = l_own * w_own + (l_sel * w_sel).sum(-1)
    out = (num / den[..., None]).astype(h.dtype).reshape(bsz, s, MOBA_HEADS * hd)
    return out @ w_o


def swiglu(h, w_gu, w_down):
    g, u = jnp.split(h @ w_gu, 2, axis=-1)
    return (jax.nn.silu(g) * u) @ w_down


def moe_swiglu(h, w_router, w_gu, w_down):
    bsz, s, d = h.shape
    xt = h.reshape(-1, d)
    n_tok = xt.shape[0]
    logits = (xt @ w_router).astype(F32)
    top_val, top_idx = lax.top_k(logits, TOP_K)
    gates = jax.nn.softmax(top_val, axis=-1)
    seg = top_idx.reshape(-1).astype(jnp.int32)
    dest, group_seg, group_used, cap = group_rows(seg, N_EXPERTS, MOE_GROUP, MOE_GROUP)
    rows = jnp.zeros((cap, d), xt.dtype).at[dest].set(jnp.repeat(xt, TOP_K, axis=0))
    out_dtype = jnp.result_type(xt, w_down)

    def step(args):
        xg, e, used = args

        def compute():
            g, u = jnp.split(xg @ w_gu[e], 2, axis=-1)
            return ((jax.nn.silu(g) * u) @ w_down[e]).astype(out_dtype)

        return lax.cond(used, compute, lambda: jnp.zeros(xg.shape, out_dtype))

    y_rows = lax.map(step, (rows.reshape(-1, MOE_GROUP, d), group_seg, group_used)).reshape(cap, d)
    y = (y_rows[dest].reshape(n_tok, TOP_K, d).astype(F32) * gates[..., None]).sum(1)
    return y.astype(h.dtype).reshape(bsz, s, d)


def setup_inputs(seed: int = 0) -> dict:
    key = jax.random.key(seed)
    ks = jax.random.split(key, 20)

    def dense(k, shape, fan_in, scale=1.0):
        return jax.random.normal(k, shape, F32) * (scale * fan_in ** -0.5)

    def gain(k, shape):
        return 1.0 + 0.02 * jax.random.normal(k, shape, F32)

    def bias(k, shape, scale=0.02):
        return scale * jax.random.normal(k, shape, F32)

    gla_in_width = 2 * GLA_DK + 2 * GLA_DV + GLA_GATE_RANK
    return {
        "x": jax.random.normal(ks[0], (BATCH, SEQ, D_MODEL), F32),
        "w_in_a": dense(ks[1], (N_A_LAYERS, D_MODEL, gla_in_width), D_MODEL),
        "w_gate_up_a": dense(ks[2], (N_A_LAYERS, GLA_GATE_RANK, GLA_DK), GLA_GATE_RANK),
        "b_gate_a": bias(ks[3], (N_A_LAYERS, GLA_DK), 0.1),
        "g_norm_a": gain(ks[4], (N_A_LAYERS, GLA_DV_HEAD)),
        "w_o_a": dense(ks[5], (N_A_LAYERS, GLA_DV, D_MODEL), GLA_DV, DEEPNORM_BETA),
        "w_kv_shared": dense(ks[6], (D_MODEL, 2 * MOBA_KV_HEADS * MOBA_HEAD_DIM), D_MODEL),
        "w_q_b": dense(ks[7], (N_B_LAYERS, D_MODEL, MOBA_HEADS * MOBA_HEAD_DIM), D_MODEL),
        "w_o_b": dense(ks[8], (N_B_LAYERS, MOBA_HEADS * MOBA_HEAD_DIM, D_MODEL), MOBA_HEADS * MOBA_HEAD_DIM, DEEPNORM_BETA),
        "ln_mix_g": gain(ks[9], (DEPTH, D_MODEL)),
        "ln_mix_b": bias(ks[10], (DEPTH, D_MODEL)),
        "w_gu_dense": dense(ks[11], (N_DENSE_LAYERS, D_MODEL, 2 * FFN_DENSE), D_MODEL),
        "w_down_dense": dense(ks[12], (N_DENSE_LAYERS, FFN_DENSE, D_MODEL), FFN_DENSE, DEEPNORM_BETA),
        "w_router": dense(ks[13], (N_MOE_LAYERS, D_MODEL, N_EXPERTS), D_MODEL),
        "w_gu_moe": dense(ks[14], (N_MOE_LAYERS, N_EXPERTS, D_MODEL, 2 * FFN_EXPERT), D_MODEL),
        "w_down_moe": dense(ks[15], (N_MOE_LAYERS, N_EXPERTS, FFN_EXPERT, D_MODEL), FFN_EXPERT, DEEPNORM_BETA),
        "ln_ffn_g": gain(ks[16], (DEPTH, D_MODEL)),
        "ln_ffn_b": bias(ks[17], (DEPTH, D_MODEL)),
    }


def reference(x, w_in_a, w_gate_up_a, b_gate_a, g_norm_a, w_o_a, w_kv_shared, w_q_b, w_o_b,
              ln_mix_g, ln_mix_b, w_gu_dense, w_down_dense, w_router, w_gu_moe, w_down_moe,
              ln_ffn_g, ln_ffn_b):
    h = x
    shared = None
    for i in range(DEPTH):
        if i < N_A_LAYERS:
            y = gla_mixer(h, w_in_a[i], w_gate_up_a[i], b_gate_a[i], g_norm_a[i], w_o_a[i])
        else:
            if shared is None:
                shared = moba_shared_kv(h, w_kv_shared)
            j = i - N_A_LAYERS
            y = moba_mixer(h, w_q_b[j], w_o_b[j], *shared)
        h = post_norm(h, y, ln_mix_g[i], ln_mix_b[i])
        if i % 2 == 0:
            y = swiglu(h, w_gu_dense[i // 2], w_down_dense[i // 2])
        else:
            y = moe_swiglu(h, w_router[i // 2], w_gu_moe[i // 2], w_down_moe[i // 2])
        h = post_norm(h, y, ln_ffn_g[i], ln_ffn_b[i])
    return h
```

```cpp
#include <hip/hip_runtime.h>
#include <cstdio>
#include <cstdint>
namespace pg8 {
#define PG8_LAS __attribute__((address_space(3)))
typedef unsigned short bf16_t;
typedef short bf16x8 __attribute__((ext_vector_type(8)));
typedef float f32x4 __attribute__((ext_vector_type(4)));
typedef unsigned u32x4 __attribute__((ext_vector_type(4)));
constexpr int BM = 256, BK = 64, HALF = 128, HTB = HALF * BK * 2  , STAGE_BYTES = 8 * HTB, NXCD = 8, WGM = 8;

__host__ __device__ __forceinline__ int lds_byte(int r, int c) { const int st = (r >> 4) * 2 + (c >> 5), rr = r & 15, cc = c & 31, ob = rr * 64 + cc * 2; return st * 1024 + (ob ^ (((ob >> 9) & 1) << 5)); }
__host__ __device__ __forceinline__ void stage_rc(int b, int& R, int& C) { const int st = b / 1024, sb = b % 1024, swz = sb ^ (((sb >> 9) & 1) << 5); R = (st >> 1) * 16 + swz / 64; C = (st & 1) * 32 + (swz % 64) / 2; }
__host__ __device__ __forceinline__ int perm32(int rho) { const int n = rho >> 4, i = rho & 15; return 8 * (i >> 2) + 4 * n + (i & 3); }

struct Unit { int pm, pn, po; };
struct Gemm { const bf16_t* A; const bf16_t* Bt; int M, N, K; int scw = 0x7F7F7F7F, sca = 0x7F7F7F7F; };

struct StaticOrder {
    int nM, nN, nwg, G, c, wgm;
    __host__ __device__ void init(int M, int N, int G_, int c_, int wgm_ = WGM) { nM = M / BM; nN = N / BM; nwg = nM * nN; G = G_; c = c_; wgm = wgm_; }
    __host__ __device__ bool next(int i, Unit& u) const {
        const long L = (long)i * G + c; if (L >= nwg) return false;
        int wgid = (int)L; { const int q = nwg / NXCD, r = nwg % NXCD, xcd = wgid % NXCD, off = wgid / NXCD; wgid = (xcd < r ? xcd * (q + 1) : r * (q + 1) + (xcd - r) * q) + off; }
        const int nig = wgm * nN, gid = wgid / nig, fm = gid * wgm, gsz = (nM - fm) < wgm ? (nM - fm) : wgm;
        u.pm = fm + ((wgid % nig) % gsz); u.pn = (wgid % nig) / gsz; u.po = u.pm; return true;
    }
    __device__ __forceinline__ void a_ready(const Unit&) const {}
    __device__ __forceinline__ void done(const Unit&) const {}
};
__device__ __forceinline__ unsigned cvt_pk_bf16(float lo, float hi) { unsigned r; asm volatile("v_cvt_pk_bf16_f32 %0, %1, %2" : "=v"(r) : "v"(lo), "v"(hi)); return r; }

struct EpiBf16Plain {
    static constexpr bool PERM = true, AFTER_DRAIN = false;
    bf16_t* O; int ldc; int ntn; float scale;
    __device__ __forceinline__ void operator()(const f32x4 (&acc)[2][2][4][2], const Unit& u, int wr, int wc, int fr, int fq) const {
        const int row0 = u.pm * BM + wr * 64 + fr; const int col0 = (u.pn % ntn) * BM + wc * 32 + 8 * fq;
#pragma unroll
        for (int ai = 0; ai < 2; ++ai)
#pragma unroll
            for (int m = 0; m < 4; ++m) { bf16_t* rowp = O + (size_t)(row0 + ai * HALF + m * 16) * ldc + col0;
#pragma unroll
                for (int bj = 0; bj < 2; ++bj) { const f32x4 v0 = acc[ai][bj][m][0] * scale, v1 = acc[ai][bj][m][1] * scale;
                    u32x4 w; w.x = cvt_pk_bf16(v0[0], v0[1]); w.y = cvt_pk_bf16(v0[2], v0[3]); w.z = cvt_pk_bf16(v1[0], v1[1]); w.w = cvt_pk_bf16(v1[2], v1[3]);
                    *(u32x4*)(rowp + bj * HALF) = w; } }
    }
};
__device__ __forceinline__ float silu_f(float x) { return x * __builtin_amdgcn_rcpf(1.0f + __builtin_amdgcn_exp2f(-1.4426950408889634f * x)); }
struct EpiSwiglu {
    static constexpr bool PERM = true, AFTER_DRAIN = false;
    bf16_t* O; int ldc; int ntn;
    __device__ __forceinline__ void operator()(const f32x4 (&acc)[2][2][4][2], const Unit& u, int wr, int wc, int fr, int fq) const {
        const int row0 = u.pm * BM + wr * 64 + fr; const int col0 = (u.pn % ntn) * HALF + wc * 32 + 8 * fq;
#pragma unroll
        for (int ai = 0; ai < 2; ++ai)
#pragma unroll
            for (int m = 0; m < 4; ++m) { bf16_t* rowp = O + (size_t)(row0 + ai * HALF + m * 16) * ldc + col0;
                const f32x4 g0 = acc[ai][0][m][0], g1 = acc[ai][0][m][1], u0 = acc[ai][1][m][0], u1 = acc[ai][1][m][1];
                u32x4 w;
                w.x = cvt_pk_bf16(silu_f(g0[0]) * u0[0], silu_f(g0[1]) * u0[1]); w.y = cvt_pk_bf16(silu_f(g0[2]) * u0[2], silu_f(g0[3]) * u0[3]);
                w.z = cvt_pk_bf16(silu_f(g1[0]) * u1[0], silu_f(g1[1]) * u1[1]); w.w = cvt_pk_bf16(silu_f(g1[2]) * u1[2], silu_f(g1[3]) * u1[3]);
                *(u32x4*)rowp = w; }
    }
};
__device__ __forceinline__ unsigned pk4_fp8(float a, float b, float c, float d) {
    a = __builtin_amdgcn_fmed3f(a, -448.f, 448.f); b = __builtin_amdgcn_fmed3f(b, -448.f, 448.f); c = __builtin_amdgcn_fmed3f(c, -448.f, 448.f); d = __builtin_amdgcn_fmed3f(d, -448.f, 448.f);
    int r = __builtin_amdgcn_cvt_pk_fp8_f32(a, b, 0, false); r = __builtin_amdgcn_cvt_pk_fp8_f32(c, d, r, true); return (unsigned)r; }
struct EpiF8Plain {
    static constexpr bool PERM = true, AFTER_DRAIN = false;
    unsigned char* O; int ldc; int ntn; float scale;
    __device__ __forceinline__ void operator()(const f32x4 (&acc)[2][2][4][2], const Unit& u, int wr, int wc, int fr, int fq) const {
        const int row0 = u.po * BM + wr * 64 + fr; const int col0 = (u.pn % ntn) * BM + wc * 32 + 8 * fq;
#pragma unroll
        for (int ai = 0; ai < 2; ++ai)
#pragma unroll
            for (int m = 0; m < 4; ++m) { unsigned char* rowp = O + (size_t)(row0 + ai * HALF + m * 16) * ldc + col0;
#pragma unroll
                for (int bj = 0; bj < 2; ++bj) { const f32x4 v0 = acc[ai][bj][m][0] * scale, v1 = acc[ai][bj][m][1] * scale;
                    const unsigned lo = pk4_fp8(v0[0], v0[1], v0[2], v0[3]), hi = pk4_fp8(v1[0], v1[1], v1[2], v1[3]);
                    *(unsigned long long*)(rowp + bj * HALF) = (unsigned long long)lo | ((unsigned long long)hi << 32); } }
    }
};
struct EpiSwigluF8 {
    static constexpr bool PERM = true, AFTER_DRAIN = false;
    unsigned char* O; int ldc; int ntn; float sout;
    __device__ __forceinline__ void operator()(const f32x4 (&acc)[2][2][4][2], const Unit& u, int wr, int wc, int fr, int fq) const {
        const int row0 = u.po * BM + wr * 64 + fr; const int col0 = (u.pn % ntn) * HALF + wc * 32 + 8 * fq;
#pragma unroll
        for (int ai = 0; ai < 2; ++ai)
#pragma unroll
            for (int m = 0; m < 4; ++m) { unsigned char* rowp = O + (size_t)(row0 + ai * HALF + m * 16) * ldc + col0;
                const f32x4 g0 = acc[ai][0][m][0], g1 = acc[ai][0][m][1], u0 = acc[ai][1][m][0] * sout, u1 = acc[ai][1][m][1] * sout;
                unsigned lo = pk4_fp8(silu_f(g0[0]) * u0[0], silu_f(g0[1]) * u0[1], silu_f(g0[2]) * u0[2], silu_f(g0[3]) * u0[3]);
                unsigned hi = pk4_fp8(silu_f(g1[0]) * u1[0], silu_f(g1[1]) * u1[1], silu_f(g1[2]) * u1[2], silu_f(g1[3]) * u1[3]);
                *(unsigned long long*)rowp = (unsigned long long)lo | ((unsigned long long)hi << 32); }
    }
};
template <bool RES_BF16> struct EpiResBf16 {
    static constexpr bool PERM = true, AFTER_DRAIN = false;
    bf16_t* T; const void* res; int ldc; float alpha;
    __device__ __forceinline__ void operator()(const f32x4 (&acc)[2][2][4][2], const Unit& u, int wr, int wc, int fr, int fq) const {
        const int row0 = u.pm * BM + wr * 64 + fr, col0 = u.pn * BM + wc * 32 + 8 * fq;
#pragma unroll
        for (int ai = 0; ai < 2; ++ai)
#pragma unroll
            for (int m = 0; m < 4; ++m) { const size_t ro = (size_t)(row0 + ai * HALF + m * 16) * ldc + col0;
#pragma unroll
                for (int bj = 0; bj < 2; ++bj) { const size_t o = ro + bj * HALF; f32x4 r0, r1;
                    if (RES_BF16) { const u32x4 q = *(const u32x4*)((const bf16_t*)res + o);
                        r0[0] = __uint_as_float(q.x << 16); r0[1] = __uint_as_float(q.x & 0xffff0000u); r0[2] = __uint_as_float(q.y << 16); r0[3] = __uint_as_float(q.y & 0xffff0000u);
                        r1[0] = __uint_as_float(q.z << 16); r1[1] = __uint_as_float(q.z & 0xffff0000u); r1[2] = __uint_as_float(q.w << 16); r1[3] = __uint_as_float(q.w & 0xffff0000u); }
                    else { r0 = *(const f32x4*)((const float*)res + o); r1 = *(const f32x4*)((const float*)res + o + 4); }
                    const f32x4 v0 = r0 * alpha + acc[ai][bj][m][0], v1 = r1 * alpha + acc[ai][bj][m][1];
                    u32x4 w; w.x = cvt_pk_bf16(v0[0], v0[1]); w.y = cvt_pk_bf16(v0[2], v0[3]); w.z = cvt_pk_bf16(v1[0], v1[1]); w.w = cvt_pk_bf16(v1[2], v1[3]);
                    *(u32x4*)(T + o) = w; } }
    }
};
template <bool RES_BF16> struct EpiLnFused {
    static constexpr bool PERM = true, AFTER_DRAIN = false;
    bf16_t* H; const void* res; int ldc; float alpha; const float* g; const float* b;
    unsigned long long* slots;
    unsigned* cnt;
    unsigned* tmo;
    PG8_LAS unsigned char* tab;
    __device__ __forceinline__ void operator()(const f32x4 (&acc)[2][2][4][2], const Unit& u, int wr, int wc, int fr, int fq) const {
        typedef float f2 __attribute__((ext_vector_type(2)));
        PG8_LAS f2* P = (PG8_LAS f2*)tab; PG8_LAS f2* S = (PG8_LAS f2*)(tab + 8192);
        const int tid = threadIdx.x, lane = tid & 63;
        const int row0 = u.pm * BM + wr * 64 + fr, col0 = u.pn * BM + wc * 32 + 8 * fq;
        f32x4 t[2][4][2][2];
#pragma unroll
        for (int ai = 0; ai < 2; ++ai)
#pragma unroll
            for (int m = 0; m < 4; ++m) { const size_t ro = (size_t)(row0 + ai * HALF + m * 16) * ldc + col0; float s = 0.f, q = 0.f;
#pragma unroll
                for (int bj = 0; bj < 2; ++bj) { const size_t o = ro + bj * HALF; f32x4 r0, r1;
                    if (RES_BF16) { const u32x4 w = *(const u32x4*)((const bf16_t*)res + o);
                        r0[0] = __uint_as_float(w.x << 16); r0[1] = __uint_as_float(w.x & 0xffff0000u); r0[2] = __uint_as_float(w.y << 16); r0[3] = __uint_as_float(w.y & 0xffff0000u);
                        r1[0] = __uint_as_float(w.z << 16); r1[1] = __uint_as_float(w.z & 0xffff0000u); r1[2] = __uint_as_float(w.w << 16); r1[3] = __uint_as_float(w.w & 0xffff0000u); }
                    else { r0 = *(const f32x4*)((const float*)res + o); r1 = *(const f32x4*)((const float*)res + o + 4); }
                    const f32x4 v0 = r0 * alpha + acc[ai][bj][m][0], v1 = r1 * alpha + acc[ai][bj][m][1];
                    t[ai][m][bj][0] = v0; t[ai][m][bj][1] = v1;
                    s += ((v0[0] + v0[1]) + (v0[2] + v0[3])) + ((v1[0] + v1[1]) + (v1[2] + v1[3]));
                    q += ((v0[0] * v0[0] + v0[1] * v0[1]) + (v0[2] * v0[2] + v0[3] * v0[3])) + ((v1[0] * v1[0] + v1[1] * v1[1]) + (v1[2] * v1[2] + v1[3] * v1[3])); }
                s += __shfl_xor(s, 16); s += __shfl_xor(s, 32); q += __shfl_xor(q, 16); q += __shfl_xor(q, 32);
                if (fq == 0) P[(ai * HALF + wr * 64 + m * 16 + fr) * 4 + wc] = (f2){s, q}; }
        asm volatile("s_waitcnt lgkmcnt(0)" ::: "memory"); __builtin_amdgcn_s_barrier(); asm volatile("" ::: "memory");
        if (tid < 256) { const f2 a = P[tid * 4 + 0], b2 = P[tid * 4 + 1], c = P[tid * 4 + 2], d = P[tid * 4 + 3];
            const float ts = (a.x + b2.x) + (c.x + d.x), tq = (a.y + b2.y) + (c.y + d.y);
            __hip_atomic_store(slots + ((size_t)u.pm * BM + tid) * 8 + u.pn, ((unsigned long long)__float_as_uint(tq) << 32) | (unsigned long long)__float_as_uint(ts), __ATOMIC_RELAXED, __HIP_MEMORY_SCOPE_AGENT);
            asm volatile("s_waitcnt vmcnt(0)" ::: "memory");
            if (lane == 0) __hip_atomic_fetch_add(cnt + 64 * u.pm, 1u, __ATOMIC_RELAXED, __HIP_MEMORY_SCOPE_AGENT); }
        if (tid < 64) { unsigned sp = 0;
            while ((unsigned)__builtin_amdgcn_readfirstlane(__hip_atomic_load(cnt + 64 * u.pm, __ATOMIC_RELAXED, __HIP_MEMORY_SCOPE_AGENT)) < 32u) {
                __builtin_amdgcn_s_sleep(2);
                if ((++sp & 255u) == 0u) { if (__hip_atomic_load(tmo, __ATOMIC_RELAXED, __HIP_MEMORY_SCOPE_AGENT) != 0u) break; if (sp > (1u << 20)) { if (tid == 0) __hip_atomic_store(tmo, 1u, __ATOMIC_RELAXED, __HIP_MEMORY_SCOPE_AGENT); break; } } }
            __builtin_amdgcn_fence(__ATOMIC_ACQUIRE, "agent"); asm volatile("s_waitcnt vmcnt(0)" ::: "memory"); }
        asm volatile("" ::: "memory"); __builtin_amdgcn_s_barrier(); asm volatile("" ::: "memory");
        if (tid < 256) { float ts = 0.f, tq = 0.f;
#pragma unroll
            for (int k = 0; k < 8; ++k) { const unsigned long long x = __hip_atomic_load(slots + ((size_t)u.pm * BM + tid) * 8 + k, __ATOMIC_RELAXED, __HIP_MEMORY_SCOPE_AGENT); ts += __uint_as_float((unsigned)x); tq += __uint_as_float((unsigned)(x >> 32)); }
            const float mean = ts * (1.0f / 2048.0f), var = tq * (1.0f / 2048.0f) - mean * mean;
            S[tid] = (f2){mean, 1.0f / sqrtf(fmaxf(var, 0.f) + 1e-5f)}; }
        asm volatile("s_waitcnt lgkmcnt(0)" ::: "memory"); __builtin_amdgcn_s_barrier(); asm volatile("" ::: "memory");
        f32x4 gv[2][2], bv[2][2];
#pragma unroll
        for (int bj = 0; bj < 2; ++bj)
#pragma unroll
            for (int n = 0; n < 2; ++n) { gv[bj][n] = *(const f32x4*)(g + col0 + bj * HALF + 4 * n); bv[bj][n] = *(const f32x4*)(b + col0 + bj * HALF + 4 * n); }
#pragma unroll
        for (int ai = 0; ai < 2; ++ai)
#pragma unroll
            for (int m = 0; m < 4; ++m) { const f2 st = S[ai * HALF + wr * 64 + m * 16 + fr]; bf16_t* rowp = H + (size_t)(row0 + ai * HALF + m * 16) * ldc + col0;
#pragma unroll
                for (int bj = 0; bj < 2; ++bj) { const f32x4 v0 = (t[ai][m][bj][0] - st.x) * st.y * gv[bj][0] + bv[bj][0], v1 = (t[ai][m][bj][1] - st.x) * st.y * gv[bj][1] + bv[bj][1];
                    u32x4 w; w.x = cvt_pk_bf16(v0[0], v0[1]); w.y = cvt_pk_bf16(v0[2], v0[3]); w.z = cvt_pk_bf16(v1[0], v1[1]); w.w = cvt_pk_bf16(v1[2], v1[3]);
                    *(u32x4*)(rowp + bj * HALF) = w; } }
    }
};
struct TableOrder {
    int pmv, pnv, pov; int n; int i0 = 0;
    __device__ __forceinline__ bool next(int i, Unit& u) const { i += i0; if (i >= n) return false; u.pm = __builtin_amdgcn_readlane(pmv, i); u.pn = __builtin_amdgcn_readlane(pnv, i); u.po = __builtin_amdgcn_readlane(pov, i); return true; }
    __device__ __forceinline__ void a_ready(const Unit&) const {}
    __device__ __forceinline__ void done(const Unit&) const {}
};
typedef int v4i_t __attribute__((ext_vector_type(4)));
typedef int v8i_t __attribute__((ext_vector_type(8)));
template <int F8> __device__ __forceinline__ void mma_blk(f32x4 (&acc)[4][2], const bf16x8 (&At)[4][2], const bf16x8 (&Bt)[2][2], int scw, int sca) {
    if constexpr (!F8) {
#pragma unroll
        for (int m = 0; m < 4; ++m)
#pragma unroll
            for (int n = 0; n < 2; ++n)
#pragma unroll
                for (int k = 0; k < 2; ++k) acc[m][n] = __builtin_amdgcn_mfma_f32_16x16x32_bf16(Bt[n][k], At[m][k], acc[m][n], 0, 0, 0);
    } else {
#pragma unroll
        for (int m = 0; m < 4; ++m)
#pragma unroll
            for (int n = 0; n < 2; ++n) {
                const v8i_t a = __builtin_shufflevector(__builtin_bit_cast(v4i_t, Bt[n][0]), __builtin_bit_cast(v4i_t, Bt[n][1]), 0, 1, 2, 3, 4, 5, 6, 7);
                const v8i_t b = __builtin_shufflevector(__builtin_bit_cast(v4i_t, At[m][0]), __builtin_bit_cast(v4i_t, At[m][1]), 0, 1, 2, 3, 4, 5, 6, 7);
                if constexpr (F8 == 1) asm volatile("v_mfma_scale_f32_16x16x128_f8f6f4 %0, %1, %2, %0, %3, %4 op_sel_hi:[0,0,0]" : "+v"(acc[m][n]) : "v"(a), "v"(b), "v"(scw), "v"(sca));
                else { typedef int v6i_t __attribute__((ext_vector_type(6)));
                    const v6i_t a6 = __builtin_shufflevector(a, a, 0, 1, 2, 3, 4, 5), b6 = __builtin_shufflevector(b, b, 0, 1, 2, 3, 4, 5);
                    asm volatile("s_nop 1\n\tv_mfma_scale_f32_16x16x128_f8f6f4 %0, %1, %2, %0, %3, %4 op_sel_hi:[0,0,0] cbsz:2 blgp:2" : "+v"(acc[m][n]) : "v"(a6), "v"(b6), "v"(a[6]), "v"(b[6])); } }
    }
}
template <class Epi, class Sched, bool ALIGN_EPI = false, bool SP2 = false, int F8 = 0>
__device__ __forceinline__ void gemm_phase(PG8_LAS unsigned char* lds, const Gemm g, const Sched& S, const Epi& E) {
    const int tid = threadIdx.x, wid = __builtin_amdgcn_readfirstlane(tid >> 6), lane = tid & 63, wr = wid >> 2, wc = wid & 3, fr = lane & 15, fq = lane >> 4;
    const int K = g.K, nt = K / BK;
    unsigned voffA[2], voffB[2];
#pragma unroll
    for (int i = 0; i < 2; ++i) { int R, C; stage_rc(tid * 16 + i * 8192, R, C); const int Rb = Epi::PERM ? ((R & ~31) + perm32(R & 31)) : R;
        voffA[i] = (unsigned)(R * K + C) * 2u; voffB[i] = (unsigned)(Rb * K + C) * 2u; }
    const size_t kstep = (size_t)(BK * 2);
    const size_t hstep = (size_t)HALF * K * 2;
    const size_t tstep = 2 * hstep;
    const unsigned ldsw = (unsigned)wid * 1024u;
    const int aoff = lds_byte(wr * 64 + fr, fq * 8), boff = lds_byte(wc * 32 + fr, fq * 8);
#define PG8_SA(b, h) (((b) * 2 + (h)) * HTB)
#define PG8_SB(b, h) ((4 + (b) * 2 + (h)) * HTB)
#define PG8_STAGE(bufoff, gbase, voff) do { _Pragma("unroll") for (int _i = 0; _i < 2; ++_i) \
        __builtin_amdgcn_global_load_lds((const unsigned*)((const char*)(gbase) + (voff)[_i]), (PG8_LAS unsigned*)(lds + (bufoff) + ldsw + _i * 8192), 16, 0, 0); } while (0)
#define PG8_LDA(dst, b, h) do { _Pragma("unroll") for (int m = 0; m < 4; ++m) _Pragma("unroll") for (int k = 0; k < 2; ++k) dst[m][k] = *(const PG8_LAS bf16x8*)(lds + PG8_SA(b, h) + aoff + m * 2048 + k * 1024); } while (0)
#define PG8_LDB(dst, b, h) do { _Pragma("unroll") for (int n = 0; n < 2; ++n) _Pragma("unroll") for (int k = 0; k < 2; ++k) dst[n][k] = *(const PG8_LAS bf16x8*)(lds + PG8_SB(b, h) + boff + n * 2048 + k * 1024); } while (0)
#define PG8_MMA(ai, bj, At, Bt) do { __builtin_amdgcn_s_setprio(1); mma_blk<F8>(acc[ai][bj], At, Bt, g.scw, g.sca); __builtin_amdgcn_s_setprio(0); } while (0)
#define PG8_WAIT_V(n) asm volatile("s_waitcnt vmcnt(" #n ")" ::: "memory")
#define PG8_WAIT_L(n) asm volatile("s_waitcnt lgkmcnt(" #n ")" ::: "memory")
#define PG8_BAR __builtin_amdgcn_s_barrier()
#define PG8_SCHED __builtin_amdgcn_sched_barrier(0)
    Unit cur, nxt; int ui = 0;
    if (!S.next(0, cur)) return;
    f32x4 acc[2][2][4][2];
#pragma unroll
    for (int a = 0; a < 2; ++a)
#pragma unroll
        for (int b = 0; b < 2; ++b)
#pragma unroll
            for (int m = 0; m < 4; ++m)
#pragma unroll
                for (int n = 0; n < 2; ++n) acc[a][b][m][n] = (f32x4){0.f, 0.f, 0.f, 0.f};
    bf16x8 At[4][2], B0[2][2], B1[2][2];
    const char* cA = (const char*)g.A + (size_t)cur.pm * tstep; const char* cB = (const char*)g.Bt + (size_t)cur.pn * tstep;
    S.a_ready(cur);
    if constexpr (SP2) {
        PG8_STAGE(PG8_SB(0, 0), cB, voffB); PG8_STAGE(PG8_SB(0, 1), cB + hstep, voffB); PG8_STAGE(PG8_SA(0, 0), cA, voffA); PG8_STAGE(PG8_SA(0, 1), cA + hstep, voffA);
        if (wr == 1) PG8_BAR;
        PG8_WAIT_V(2); PG8_BAR;
        PG8_STAGE(PG8_SB(1, 0), cB + kstep, voffB); PG8_STAGE(PG8_SA(1, 0), cA + kstep, voffA); PG8_STAGE(PG8_SB(1, 1), cB + hstep + kstep, voffB);
        PG8_WAIT_V(6); PG8_BAR;
    } else {
        PG8_STAGE(PG8_SB(0, 0), cB, voffB); PG8_STAGE(PG8_SA(0, 0), cA, voffA); PG8_STAGE(PG8_SB(0, 1), cB + hstep, voffB); PG8_STAGE(PG8_SA(0, 1), cA + hstep, voffA);
        if (wr == 1) PG8_BAR;
        PG8_WAIT_V(4); PG8_BAR;
        PG8_STAGE(PG8_SB(1, 0), cB + kstep, voffB); PG8_STAGE(PG8_SA(1, 0), cA + kstep, voffA); PG8_STAGE(PG8_SB(1, 1), cB + hstep + kstep, voffB);
        PG8_WAIT_V(6); PG8_BAR;
    }
    for (;;) {
        const bool has_next = S.next(ui + 1, nxt);
        const char* nA = has_next ? (const char*)g.A + (size_t)nxt.pm * tstep : cA; const char* nB = has_next ? (const char*)g.Bt + (size_t)nxt.pn * tstep : cB;
        for (int t = 0; t < nt; t += 2) {
            const bool last = (t == nt - 2);
            const char* a1 = cA + (size_t)(t + 1) * kstep;
            const char* a2 = last ? nA : cA + (size_t)(t + 2) * kstep; const char* b2 = last ? nB : cB + (size_t)(t + 2) * kstep;
            const char* a3 = a2 + kstep; const char* b3 = b2 + kstep;
            if (last && has_next) S.a_ready(nxt);
            if constexpr (SP2) {
            PG8_LDB(B0, 0, 0); PG8_LDB(B1, 0, 1); PG8_SCHED; PG8_LDA(At, 0, 0); PG8_STAGE(PG8_SA(1, 1), a1 + hstep, voffA);
            PG8_WAIT_V(8); PG8_WAIT_L(0); PG8_BAR; PG8_MMA(0, 0, At, B0); PG8_MMA(0, 1, At, B1); PG8_BAR; PG8_SCHED;
            PG8_LDA(At, 0, 1); PG8_STAGE(PG8_SB(0, 0), b2, voffB); PG8_STAGE(PG8_SB(0, 1), b2 + hstep, voffB); PG8_STAGE(PG8_SA(0, 0), a2, voffA);
            PG8_WAIT_V(8); PG8_WAIT_L(0); PG8_BAR; PG8_MMA(1, 0, At, B0); PG8_MMA(1, 1, At, B1); PG8_BAR; PG8_SCHED;
            PG8_LDB(B0, 1, 0); PG8_LDB(B1, 1, 1); PG8_SCHED; PG8_LDA(At, 1, 0); PG8_STAGE(PG8_SA(0, 1), a2 + hstep, voffA);
            PG8_WAIT_V(8); PG8_WAIT_L(0); PG8_BAR; PG8_MMA(0, 0, At, B0); PG8_MMA(0, 1, At, B1); PG8_BAR; PG8_SCHED;
            PG8_LDA(At, 1, 1); PG8_STAGE(PG8_SB(1, 0), b3, voffB); PG8_STAGE(PG8_SB(1, 1), b3 + hstep, voffB); PG8_STAGE(PG8_SA(1, 0), a3, voffA);
            PG8_WAIT_V(8); PG8_WAIT_L(0); PG8_BAR; PG8_MMA(1, 0, At, B0); PG8_MMA(1, 1, At, B1); PG8_BAR; PG8_SCHED;
            } else {
            PG8_LDB(B0, 0, 0); PG8_SCHED; PG8_LDA(At, 0, 0); PG8_STAGE(PG8_SA(1, 1), a1 + hstep, voffA);
            PG8_WAIT_L(8); PG8_BAR; PG8_WAIT_L(0); PG8_MMA(0, 0, At, B0); PG8_BAR; PG8_SCHED;
            PG8_LDB(B1, 0, 1); PG8_STAGE(PG8_SB(0, 0), b2, voffB);
            PG8_BAR; PG8_WAIT_L(0); PG8_MMA(0, 1, At, B1); PG8_BAR;
            PG8_LDA(At, 0, 1); PG8_STAGE(PG8_SA(0, 0), a2, voffA);
            PG8_BAR; PG8_WAIT_L(0); PG8_MMA(1, 0, At, B0); PG8_BAR; PG8_SCHED;
            PG8_STAGE(PG8_SB(0, 1), b2 + hstep, voffB);
            PG8_WAIT_V(6); PG8_BAR; PG8_MMA(1, 1, At, B1); PG8_BAR;
            PG8_LDB(B0, 1, 0); PG8_SCHED; PG8_LDA(At, 1, 0); PG8_STAGE(PG8_SA(0, 1), a2 + hstep, voffA);
            PG8_WAIT_L(8); PG8_BAR; PG8_WAIT_L(0); PG8_MMA(0, 0, At, B0); PG8_BAR; PG8_SCHED;
            PG8_LDB(B1, 1, 1); PG8_STAGE(PG8_SB(1, 0), b3, voffB);
            PG8_BAR; PG8_WAIT_L(0); PG8_MMA(0, 1, At, B1); PG8_BAR;
            PG8_LDA(At, 1, 1); PG8_STAGE(PG8_SA(1, 0), a3, voffA);
            PG8_BAR; PG8_WAIT_L(0); PG8_MMA(1, 0, At, B0); PG8_BAR; PG8_SCHED;
            PG8_STAGE(PG8_SB(1, 1), b3 + hstep, voffB);
            PG8_WAIT_V(6); PG8_BAR; PG8_MMA(1, 1, At, B1); PG8_BAR;
            }
        }
        if constexpr (ALIGN_EPI) { if (wr == 0) PG8_BAR; }
        if constexpr (F8) asm volatile("s_nop 15\n\ts_nop 15" ::: "memory");
        if constexpr (!Epi::AFTER_DRAIN) { E(acc, cur, wr, wc, fr, fq); S.done(cur); }
        if (!has_next) break;
#pragma unroll
        for (int a = 0; a < 2; ++a)
#pragma unroll
            for (int b = 0; b < 2; ++b)
#pragma unroll
                for (int m = 0; m < 4; ++m)
#pragma unroll
                    for (int n = 0; n < 2; ++n) acc[a][b][m][n] = (f32x4){0.f, 0.f, 0.f, 0.f};
        cur = nxt; cA = nA; cB = nB; ++ui;
        if constexpr (ALIGN_EPI) { if (wr == 1) PG8_BAR; }
    }
    PG8_WAIT_V(0);
    if constexpr (!ALIGN_EPI) { if (wr == 0) PG8_BAR; }
    PG8_BAR;
    if constexpr (Epi::AFTER_DRAIN) { E.fused(acc, cur, wr, wc, fr, fq, lds, wid, lane); S.done(cur); }
#undef PG8_SA
#undef PG8_SB
#undef PG8_STAGE
#undef PG8_LDA
#undef PG8_LDB
#undef PG8_MMA
#undef PG8_WAIT_V
#undef PG8_WAIT_L
#undef PG8_BAR
#undef PG8_SCHED
}
}

#ifndef PG8_SP2
#define PG8_SP2 true
#endif
#ifndef PG8_ALIGN
#define PG8_ALIGN true
#endif
constexpr int NWAVES = 8;
#ifndef MK_ONE_LAUNCH
#define MK_ONE_LAUNCH 1
#endif
constexpr int NPH = 19;

constexpr int NB = 4, SEQ = 4096, D = 2048, NTOK = NB * SEQ;
constexpr int GH = 4, GDK = 256, GDV = 512, NIN = 6144, LDW_IN = 6160;
constexpr int FD = 5504, NE = 8, FE = 7168;
constexpr int MH = 16, MKV = 4, HD = 128, MBLK = 256, NBLK = 16, NKVQ = 3072;
constexpr int XG_ROWS = 34816;
constexpr float ALPHA = 1.41421356237309515f;
constexpr float LN_EPS = 1e-5f, RMS_EPS = 1e-6f;
constexpr float WSC_GU = 64.f, WSC_DN = 256.f, XSC = 4.f, ASC = 4.f, WSC_OB = 128.f, OSC = 32.f, YSC = 8.f;

constexpr size_t MiB = 1u << 20;
constexpr size_t WS_CTL = 0, CTL_ZERO_BYTES = 1 * MiB;
constexpr size_t WS_W_IN = 2 * MiB;
constexpr size_t WS_W_OA = WS_W_IN + (size_t)NIN * D * 2;
constexpr size_t WS_W_GUD = WS_W_OA + (size_t)D * D * 2;
constexpr size_t WS_W_DD = WS_W_GUD + (size_t)2 * FD * D * 2;
constexpr size_t WS_W_KVQ = WS_W_DD + (size_t)D * FD * 2;
constexpr size_t WS_W_OB = WS_W_KVQ + (size_t)NKVQ * D * 2;
constexpr size_t WS_W_GUM = WS_W_OB + (size_t)D * D * 2;
constexpr size_t WS_W_DM = WS_W_GUM + (size_t)NE * 2 * FE * D * 2;
constexpr size_t WS_XB = WS_W_DM + (size_t)NE * D * FE * 2;
constexpr size_t WS_PROJ = WS_XB + (size_t)NTOK * D * 2;
constexpr size_t WS_LA = WS_PROJ + (size_t)NTOK * NIN * 2;
constexpr size_t WS_OGLA = WS_LA + (size_t)NTOK * 1024 * 4;
constexpr size_t WS_A3 = WS_OGLA + (size_t)NTOK * D * 4;
constexpr size_t WS_T = WS_A3 + (size_t)NTOK * D * 2;
constexpr size_t WS_H1 = WS_T + (size_t)NTOK * D * 4;
constexpr size_t WS_H2 = WS_H1 + (size_t)NTOK * D * 2;
constexpr size_t WS_H3 = WS_H2 + (size_t)NTOK * D * 2;
constexpr size_t WS_ACT = WS_H3 + (size_t)NTOK * D * 2;
constexpr size_t WS_KVQ = WS_ACT + (size_t)NTOK * FD * 2;
constexpr size_t WS_KM = WS_KVQ + (size_t)NTOK * NKVQ * 2;
constexpr size_t WS_XG = WS_KM + 1 * MiB;
constexpr size_t WS_ACTM = WS_XG + (size_t)NE * NTOK * D;
constexpr size_t WS_Y = WS_ACTM + (size_t)XG_ROWS * FE * 2;
constexpr size_t WS_TOKINFO = WS_Y + (size_t)XG_ROWS * D * 2;
constexpr size_t WS_LIST = WS_TOKINFO + (size_t)NTOK * 32;
constexpr size_t WS_QD = WS_LIST + (size_t)NE * NTOK * 4;
constexpr size_t WS_KET = WS_QD + (size_t)NTOK * 1024 * 2;
constexpr size_t WS_VT = WS_KET + (size_t)NTOK * 1024 * 2;
constexpr size_t WS_ATTG = WS_VT + (size_t)NTOK * 2048 * 2;
constexpr size_t WS_DEC = WS_ATTG + (size_t)1024 * 64 * 64 * 2;
constexpr size_t WS_SLOTS = WS_DEC + (size_t)1024 * 256 * 4;
constexpr size_t WS_K8 = WS_SLOTS + (size_t)3 * NTOK * 8 * 8;
constexpr size_t WS_V8T = WS_K8 + (size_t)NTOK * 512;
constexpr size_t WS_END = WS_V8T + (size_t)NTOK * 512;
constexpr int CW_CNT = 1024;
constexpr int CW_BAR = 4096;
constexpr int CW_XRANK = 3072;
constexpr int CW_SCANQ = 2048;
constexpr int CW_TMO = 8, CW_PANEL = 16384;

constexpr int RING_OFF = 0, RING_BYTES = 135168;
constexpr int LDSCTL_OFF = RING_BYTES, MISC_OFF = LDSCTL_OFF + 320, TAB_OFF = LDSCTL_OFF + 1024, LNTAB_OFF = LDSCTL_OFF + 2048;
constexpr int LDS_BYTES = 147456;
static_assert(TAB_OFF + 768 <= LNTAB_OFF && LNTAB_OFF + 10240 <= LDS_BYTES, "LDS map");

#define GAS __attribute__((address_space(1)))
#define LAS __attribute__((address_space(3)))
typedef unsigned short bf16;
typedef unsigned v4u __attribute__((ext_vector_type(4)));
typedef unsigned v2u __attribute__((ext_vector_type(2)));
typedef float f32x4 __attribute__((ext_vector_type(4)));
typedef float f32x16 __attribute__((ext_vector_type(16)));
typedef short bf16x8 __attribute__((ext_vector_type(8)));
typedef short s16x4 __attribute__((ext_vector_type(4)));
typedef GAS unsigned gu32;
#define LDS_WAIT() asm volatile("s_waitcnt lgkmcnt(0)" ::: "memory")
#define VM_WAIT() asm volatile("s_waitcnt vmcnt(0)" ::: "memory")
__device__ __forceinline__ unsigned pk2(float lo, float hi) { unsigned r; asm volatile("v_cvt_pk_bf16_f32 %0, %1, %2" : "=v"(r) : "v"(lo), "v"(hi)); return r; }
__device__ __forceinline__ float bflo(unsigned u) { return __uint_as_float(u << 16); }
__device__ __forceinline__ float bfhi(unsigned u) { return __uint_as_float(u & 0xffff0000u); }
__device__ __forceinline__ float bf1(bf16 b) { return __uint_as_float((unsigned)b << 16); }
__device__ __forceinline__ float wave_sum(float v) {
#pragma unroll
    for (int o = 1; o < 64; o <<= 1) v += __shfl_xor(v, o);
    return v;
}
__device__ __forceinline__ float silu1(float x) { return x / (1.0f + __expf(-x)); }

#define MFMA32(a, b, c) __builtin_amdgcn_mfma_f32_32x32x16_bf16((a), (b), (c), 0, 0, 0)
#define RAW_BAR() do { asm volatile("s_waitcnt lgkmcnt(0)" ::: "memory"); __builtin_amdgcn_s_barrier(); asm volatile("" ::: "memory"); } while (0)
#define XB_TMO      128
#define XB_XCNT(j)  (256  + 64 * (j))
#define XB_XSUB(j)  (1280 + 64 * (j))
#define XB_XGEN(j)  (2304 + 64 * (j))
#define XB_TOP      3328
#define XB_TOPGEN   3392
#define XCD_BAR_WORDS 3456
#define XB_SPIN_CAP (1u << 18)

__device__ __forceinline__ unsigned xb_ld(unsigned* p)              { return __hip_atomic_load(p, __ATOMIC_RELAXED, __HIP_MEMORY_SCOPE_AGENT); }
__device__ __forceinline__ unsigned xb_add(unsigned* p, unsigned v) { return __hip_atomic_fetch_add(p, v, __ATOMIC_RELAXED, __HIP_MEMORY_SCOPE_AGENT); }
__device__ __forceinline__ unsigned xb_xcc_id() { return (unsigned)__builtin_amdgcn_s_getreg((3 << 11) | 20) & 0xFu; }
#define XB_SPIN(cond, bar) do { unsigned _sp = 0; while (cond) { __builtin_amdgcn_s_sleep(1); \
    if ((++_sp & 255u) == 0u) { if (xb_ld(&(bar)[XB_TMO])) break; if (_sp > XB_SPIN_CAP) { atomicAdd(&(bar)[XB_TMO], 1u); break; } } } } while (0)

struct XcdBarrier {
    unsigned* bar; unsigned x;
    volatile LAS unsigned* st;
};

__device__ __forceinline__ XcdBarrier xcd_barrier_post(unsigned* bar, volatile LAS unsigned* st) {
    XcdBarrier b; b.bar = bar; b.x = xb_xcc_id(); b.st = st;
    if (threadIdx.x == 0) (void)xb_add(&bar[XB_XCNT(b.x)], 1u);
    return b;
}
__device__ __forceinline__ void xcd_barrier_complete(unsigned* bar, unsigned x, unsigned& nloc, unsigned& nx) {
    const unsigned G = gridDim.x * gridDim.y * gridDim.z;
    unsigned sum, cnt, mine, sp = 0u;
    for (;;) {
        sum = 0u; cnt = 0u; mine = 0u;
#pragma unroll
        for (unsigned j = 0; j < 16; ++j) { const unsigned c = xb_ld(&bar[XB_XCNT(j)]); sum += c; cnt += (c > 0u) ? 1u : 0u; mine = (j == x) ? c : mine; }
        if (sum == G) break;
        __builtin_amdgcn_s_sleep(1);
        if ((++sp & 255u) == 0u) { if (xb_ld(&bar[XB_TMO])) break; if (sp > XB_SPIN_CAP) { atomicAdd(&bar[XB_TMO], 1u); break; } }
    }
    nloc = mine > 0u ? mine : 1u; nx = cnt > 0u ? cnt : 1u;
}

__device__ __forceinline__ void xcd_barrier(const XcdBarrier& b) {
    asm volatile("s_waitcnt vmcnt(0)" ::: "memory");
    __syncthreads();
    if (threadIdx.x == 0) {
        unsigned* bar = b.bar;
        __builtin_amdgcn_s_waitcnt(0);
        unsigned nloc = b.st[0], nx = b.st[1];
        if (nloc == 0u) { xcd_barrier_complete(bar, b.x, nloc, nx); b.st[0] = nloc; b.st[1] = nx; }
        const unsigned old = xb_add(&bar[XB_XSUB(b.x)], 1u);
        const unsigned gen = old / nloc;
        if (old + 1u == (gen + 1u) * nloc) {
            __builtin_amdgcn_fence(__ATOMIC_RELEASE, "agent");
            asm volatile("s_waitcnt vmcnt(0)" ::: "memory");
            const unsigned og = xb_add(&bar[XB_TOP], 1u);
            const unsigned tg = og / nx;
            if (og + 1u == (tg + 1u) * nx) xb_add(&bar[XB_TOPGEN], 1u);
            else XB_SPIN(xb_ld(&bar[XB_TOPGEN]) == tg, bar);
            __builtin_amdgcn_fence(__ATOMIC_ACQUIRE, "agent");
            xb_add(&bar[XB_XGEN(b.x)], 1u);
            asm volatile("s_waitcnt vmcnt(0)" ::: "memory");
        } else {
            XB_SPIN(xb_ld(&bar[XB_XGEN(b.x)]) == gen, bar);
            __builtin_amdgcn_fence(__ATOMIC_ACQUIRE, "agent");
            asm volatile("s_waitcnt vmcnt(0)" ::: "memory");
        }
    }
    __syncthreads();
}


struct Frame {
    LAS unsigned char* lds;
    volatile LAS unsigned* MISC;
    gu32* ctl;
    int tid, lane, wave;
    int G;
    unsigned char* ws;
    const float* in[18];
    float* out;
};
#define WSP(T, off) ((T*)(F.ws + (off)))

__device__ __forceinline__ void tr_item(const float* W, size_t ldw, int k0, int n0, bf16* WT, size_t drow0, int Kd, float scale, LAS float* scr, int lane) {
    { float t_[32]; const float* wp = W + (size_t)(k0 + (lane >> 5)) * ldw + n0 + (lane & 31);
#pragma unroll
      for (int i = 0; i < 32; ++i) t_[i] = wp[(size_t)(2 * i) * ldw];
#pragma unroll
      for (int i = 0; i < 32; ++i) scr[(2 * i + (lane >> 5)) * 33 + (lane & 31)] = t_[i]; }
    LDS_WAIT(); asm volatile("" ::: "memory");
    const int c = lane & 7;
#pragma unroll
    for (int j = 0; j < 4; ++j) { const int n = (lane >> 3) + 8 * j; const LAS float* s = scr + (8 * c) * 33 + n;
        v4u o; o.x = pk2(s[0 * 33] * scale, s[1 * 33] * scale); o.y = pk2(s[2 * 33] * scale, s[3 * 33] * scale); o.z = pk2(s[4 * 33] * scale, s[5 * 33] * scale); o.w = pk2(s[6 * 33] * scale, s[7 * 33] * scale);
        *(GAS v4u*)(WT + (drow0 + n) * (size_t)Kd + k0 + 8 * c) = o; }
    LDS_WAIT(); asm volatile("" ::: "memory");
}
__device__ __forceinline__ unsigned pk4f8(float a, float b, float c, float d) { int r = __builtin_amdgcn_cvt_pk_fp8_f32(a, b, 0, false); r = __builtin_amdgcn_cvt_pk_fp8_f32(c, d, r, true); return (unsigned)r; }
__device__ __forceinline__ void tr_item_f8(const float* W, size_t ldw, int k0, int n0, unsigned char* WT, size_t drow0, int Kd, float scale, LAS float* scr, int lane) {
    const float* wp = W + (size_t)(k0 + (lane >> 5)) * ldw + n0 + (lane & 31);
#pragma unroll
    for (int hb = 0; hb < 2; ++hb) { float t_[32];
#pragma unroll
        for (int i = 0; i < 32; ++i) t_[i] = wp[(size_t)(64 * hb + 2 * i) * ldw];
#pragma unroll
        for (int i = 0; i < 32; ++i) scr[(64 * hb + 2 * i + (lane >> 5)) * 33 + (lane & 31)] = t_[i]; }
    LDS_WAIT(); asm volatile("" ::: "memory");
    const int c = lane & 7;
#pragma unroll
    for (int j = 0; j < 4; ++j) { const int n = (lane >> 3) + 8 * j; const LAS float* s = scr + (16 * c) * 33 + n;
        v4u o; o.x = pk4f8(s[0 * 33] * scale, s[1 * 33] * scale, s[2 * 33] * scale, s[3 * 33] * scale); o.y = pk4f8(s[4 * 33] * scale, s[5 * 33] * scale, s[6 * 33] * scale, s[7 * 33] * scale);
        o.z = pk4f8(s[8 * 33] * scale, s[9 * 33] * scale, s[10 * 33] * scale, s[11 * 33] * scale); o.w = pk4f8(s[12 * 33] * scale, s[13 * 33] * scale, s[14 * 33] * scale, s[15 * 33] * scale);
        *(GAS v4u*)(WT + (drow0 + n) * (size_t)Kd + k0 + 16 * c) = o; }
    LDS_WAIT(); asm volatile("" ::: "memory");
}
typedef float v16f __attribute__((ext_vector_type(16)));
typedef int v6i_t __attribute__((ext_vector_type(6)));
__device__ __forceinline__ float amax3(float a, float b, float c) { float r; asm("v_max3_f32 %0, |%1|, |%2|, |%3|" : "=v"(r) : "v"(a), "v"(b), "v"(c)); return r; }
__device__ __forceinline__ void mx6_record(const v16f& x0, const v16f& x1, v4u& p0, v4u& p1) {
    float m0 = amax3(x0[0], x0[1], x0[2]), m1 = amax3(x1[0], x1[1], x1[2]);
#pragma unroll
    for (int i = 3; i < 15; i += 2) { m0 = amax3(m0, x0[i], x0[i + 1]); m1 = amax3(m1, x1[i], x1[i + 1]); }
    const float mx = amax3(m0, m1, x0[15]), mx2 = amax3(mx, x1[15], x1[15]);
    unsigned sb = (__float_as_uint(mx2 * 0.13333334f) + 0x007FFFFFu) & 0x7F800000u;
    sb = sb < 0x00800000u ? 0x00800000u : sb;
    const v6i_t r = __builtin_amdgcn_cvt_scalef32_2xpk16_fp6_f32(x0, x1, __uint_as_float(sb));
    p0 = (v4u){(unsigned)r[0], (unsigned)r[1], (unsigned)r[2], (unsigned)r[3]}; p1 = (v4u){(unsigned)r[4], (unsigned)r[5], sb >> 23, 0u};
}
__device__ __forceinline__ void tr_item_f6(const float* W, size_t ldw, int k0, int n0, unsigned char* WT, size_t drow0, int Kd, LAS float* scr, int lane) {
    const float* wp = W + (size_t)(k0 + (lane >> 5)) * ldw + n0 + (lane & 31);
#pragma unroll
    for (int hb = 0; hb < 2; ++hb) { float t_[32];
#pragma unroll
        for (int i = 0; i < 32; ++i) t_[i] = wp[(size_t)(64 * hb + 2 * i) * ldw];
#pragma unroll
        for (int i = 0; i < 32; ++i) scr[(64 * hb + 2 * i + (lane >> 5)) * 33 + (lane & 31)] = t_[i]; }
    LDS_WAIT(); asm volatile("" ::: "memory");
    const int q = lane & 3;
#pragma unroll
    for (int j = 0; j < 2; ++j) { const int n = (lane >> 2) + 16 * j; const LAS float* s = scr + (32 * q) * 33 + n;
        v16f x0, x1;
#pragma unroll
        for (int i = 0; i < 16; ++i) { x0[i] = s[i * 33]; x1[i] = s[(16 + i) * 33]; }
        v4u p0, p1; mx6_record(x0, x1, p0, p1);
        unsigned char* o = WT + (drow0 + n) * (size_t)Kd + k0 + 16 * q;
        *(GAS v4u*)o = p0; *(GAS v4u*)(o + 64) = p1; }
    LDS_WAIT(); asm volatile("" ::: "memory");
}
template <int PART, bool RO = false> __device__ __forceinline__ void p0_expert(Frame& F) {
    LAS float* scr = (LAS float*)(F.lds + RING_OFF + F.wave * 16896);
    const int gw = blockIdx.x * NWAVES + F.wave, NGW = F.G * NWAVES, lane = F.lane;
    constexpr int I_GUM1 = 16 * 448, I_DM1 = 56 * 64, N = PART == 1 ? NE * I_GUM1 : NE * I_DM1;
    constexpr size_t ldw = PART == 1 ? (size_t)2 * FE : (size_t)D;
#define P0E_SRC(r_) (PART == 1 ? F.in[14] + (size_t)((r_) / I_GUM1) * D * 2 * FE + (size_t)(128 * (((r_) % I_GUM1) / 448) + (lane >> 5)) * ldw + (((((r_) % I_GUM1) % 448) & 7) >> 2) * FE + ((((r_) % I_GUM1) % 448) >> 3) * 128 + (((((r_) % I_GUM1) % 448) & 7) & 3) * 32 + (lane & 31) \
                              : F.in[15] + (size_t)((r_) / I_DM1) * FE * D + (size_t)(128 * (((r_) % I_DM1) / 64) + (lane >> 5)) * ldw + 32 * (((r_) % I_DM1) % 64) + (lane & 31))
    float t_[64];
    int r = gw;
    if (r < N) { const float* wp = P0E_SRC(r);
#pragma unroll
        for (int i = 0; i < 64; ++i) t_[i] = wp[(size_t)(2 * i) * ldw]; }
    while (r < N) {
#pragma unroll
        for (int i = 0; i < 64; ++i) scr[(2 * i + (lane >> 5)) * 33 + (lane & 31)] = t_[i];
        const int rn = r + NGW;
        if (rn < N) { const float* wp = P0E_SRC(rn);
#pragma unroll
            for (int i = 0; i < 64; ++i) t_[i] = wp[(size_t)(2 * i) * ldw]; }
        LDS_WAIT(); asm volatile("" ::: "memory");
        if (RO) { r = rn; continue; }
        if (PART == 1) { const int e = r / I_GUM1, rr = r % I_GUM1, kb = rr / 448, nb = rr % 448; unsigned char* WT = WSP(unsigned char, WS_W_GUM); const size_t drow0 = (size_t)e * 2 * FE + 32 * nb; const int k0 = 128 * kb;
            const int q = lane & 3;
#pragma unroll
            for (int j = 0; j < 2; ++j) { const int n = (lane >> 2) + 16 * j; const LAS float* s = scr + (32 * q) * 33 + n;
                v16f x0, x1;
#pragma unroll
                for (int i = 0; i < 16; ++i) { x0[i] = s[i * 33]; x1[i] = s[(16 + i) * 33]; }
                v4u p0, p1; mx6_record(x0, x1, p0, p1);
                unsigned char* o = WT + (drow0 + n) * (size_t)D + k0 + 16 * q;
                *(GAS v4u*)o = p0; *(GAS v4u*)(o + 64) = p1; } }
        else { const int e = r / I_DM1, rr = r % I_DM1, kb = rr / 64, nb = rr % 64; unsigned char* WT = WSP(unsigned char, WS_W_DM); const size_t drow0 = (size_t)e * D + 32 * nb; const int k0 = 128 * kb; const float scale = WSC_DN;
            const int c = lane & 7;
#pragma unroll
            for (int j = 0; j < 4; ++j) { const int n = (lane >> 3) + 8 * j; const LAS float* s = scr + (16 * c) * 33 + n;
                v4u o; o.x = pk4f8(s[0 * 33] * scale, s[1 * 33] * scale, s[2 * 33] * scale, s[3 * 33] * scale); o.y = pk4f8(s[4 * 33] * scale, s[5 * 33] * scale, s[6 * 33] * scale, s[7 * 33] * scale);
                o.z = pk4f8(s[8 * 33] * scale, s[9 * 33] * scale, s[10 * 33] * scale, s[11 * 33] * scale); o.w = pk4f8(s[12 * 33] * scale, s[13 * 33] * scale, s[14 * 33] * scale, s[15 * 33] * scale);
                *(GAS v4u*)(WT + (drow0 + n) * (size_t)FE + k0 + 16 * c) = o; } }
        LDS_WAIT(); asm volatile("" ::: "memory");
        r = rn;
    }
#undef P0E_SRC
}
template <int PART> __device__ __forceinline__ void p0_prologue(Frame& F) {
    LAS float* scr = (LAS float*)(F.lds + RING_OFF + F.wave * 16896);
    const int gw = blockIdx.x * NWAVES + F.wave, NGW = F.G * NWAVES, lane = F.lane;
    constexpr int I_IN = 32 * 192, I_OA = 32 * 64, I_GUD = 32 * 344, I_DD = 86 * 64, I_KV = 32 * 32, I_Q = 32 * 64, I_OB = 16 * 64, I_GUM1 = 16 * 448, I_DM1 = 56 * 64;
    constexpr int NITEMS = I_IN + I_OA + I_GUD + I_DD + I_KV + I_Q + I_OB + NE * I_GUM1 + NE * I_DM1;
    constexpr int NDENSE = I_IN + I_OA + I_GUD + I_DD + I_KV + I_Q + I_OB;
    for (int it = (PART == 0 ? 0 : NDENSE) + gw; it < (PART == 0 ? NDENSE : NITEMS); it += NGW) {
        int r = it;
        if (r < I_IN) { const int kb = r / 192, nb = r % 192; tr_item(F.in[1], LDW_IN, 64 * kb, 32 * nb, WSP(bf16, WS_W_IN), 32 * nb, D, nb < 32 ? 0.0625f : 1.0f, scr, lane); continue; } r -= I_IN;
        if (r < I_OA) { const int kb = r / 64, nb = r % 64; tr_item(F.in[5], D, 64 * kb, 32 * nb, WSP(bf16, WS_W_OA), 32 * nb, D, 1.0f, scr, lane); continue; } r -= I_OA;
        if (r < I_GUD) { const int kb = r / 344, nb = r % 344, pn = nb >> 3, q = nb & 7, half = q >> 2, cg = q & 3;
            tr_item(F.in[11], 2 * FD, 64 * kb, half * FD + pn * 128 + cg * 32, WSP(bf16, WS_W_GUD), 32 * nb, D, 1.0f, scr, lane); continue; } r -= I_GUD;
        if (r < I_DD) { const int kb = r / 64, nb = r % 64; tr_item(F.in[12], D, 64 * kb, 32 * nb, WSP(bf16, WS_W_DD), 32 * nb, FD, 1.0f, scr, lane); continue; } r -= I_DD;
        if (r < I_KV) { const int kb = r / 32, nb = r % 32; tr_item(F.in[6], 1024, 64 * kb, 32 * nb, WSP(bf16, WS_W_KVQ), 32 * nb, D, 1.0f, scr, lane); continue; } r -= I_KV;
        if (r < I_Q) { const int kb = r / 64, nb = r % 64; tr_item(F.in[7], D, 64 * kb, 32 * nb, WSP(bf16, WS_W_KVQ), 1024 + 32 * nb, D, 0.08838834764831845f, scr, lane); continue; } r -= I_Q;
        if (r < I_OB) { const int kb = r / 64, nb = r % 64; tr_item_f8(F.in[8], D, 128 * kb, 32 * nb, WSP(unsigned char, WS_W_OB), 32 * nb, D, WSC_OB, scr, lane); continue; } r -= I_OB;
        if (r < NE * I_GUM1) { const int e = r / I_GUM1, rr = r % I_GUM1, kb = rr / 448, nb = rr % 448, pn = nb >> 3, q = nb & 7, half = q >> 2, cg = q & 3;
            tr_item_f6(F.in[14] + (size_t)e * D * 2 * FE, 2 * FE, 128 * kb, half * FE + pn * 128 + cg * 32, WSP(unsigned char, WS_W_GUM), (size_t)e * 2 * FE + 32 * nb, D, scr, lane); continue; } r -= NE * I_GUM1;
        { const int e = r / I_DM1, rr = r % I_DM1, kb = rr / 64, nb = rr % 64;
            tr_item_f8(F.in[15] + (size_t)e * FE * D, D, 128 * kb, 32 * nb, WSP(unsigned char, WS_W_DM), (size_t)e * D + 32 * nb, FE, WSC_DN, scr, lane); }
    }
    const float* x = F.in[0]; bf16* xb = WSP(bf16, WS_XB);
    if (PART == 0) for (size_t i = (size_t)blockIdx.x * 512 + F.tid; i < (size_t)NTOK * D / 8; i += (size_t)F.G * 512) {
        const f32x4 a = *(const GAS f32x4*)(x + i * 8), b = *(const GAS f32x4*)(x + i * 8 + 4);
        v4u o; o.x = pk2(a[0], a[1]); o.y = pk2(a[2], a[3]); o.z = pk2(b[0], b[1]); o.w = pk2(b[2], b[3]);
        *(GAS v4u*)(xb + i * 8) = o; }
}

#define MFMA16G(a, b, c) __builtin_amdgcn_mfma_f32_16x16x32_bf16((a), (b), (c), 0, 0, 0)
constexpr int WZP = 2056;
__device__ __forceinline__ void p1_gate(Frame& F) {
    LAS bf16* wzt = (LAS bf16*)(F.lds + RING_OFF);
    LAS bf16* wgt = wzt + 16 * WZP;
    LAS float* zp = (LAS float*)(wgt + 1024 * 16);
    LAS bf16* zt = (LAS bf16*)(zp + 4 * 64 * 4);
    const float* w_in = F.in[1]; const float* wg = F.in[2]; const float* bg = F.in[3];
    const bf16* xb = WSP(bf16, WS_XB); float* la = WSP(float, WS_LA);
    const int tid = F.tid, lane = F.lane, w = F.wave, fr = lane & 15, fq = lane >> 4;
    { const int n = tid & 15, kg = tid >> 4;
#pragma unroll 2
      for (int i = 0; i < 8; ++i) { const int k0 = kg * 64 + 8 * i; const float* p = w_in + (size_t)k0 * LDW_IN + NIN + n;
          v4u o; o.x = pk2(p[0], p[LDW_IN]); o.y = pk2(p[2 * LDW_IN], p[3 * LDW_IN]); o.z = pk2(p[4 * LDW_IN], p[5 * LDW_IN]); o.w = pk2(p[6 * LDW_IN], p[7 * LDW_IN]);
          *(LAS v4u*)(wzt + n * WZP + k0) = o; } }
#pragma unroll
    for (int r = 0; r < 2; ++r) { const int n = tid + 512 * r; const float* p = wg + n;
        v4u o0, o1; o0.x = pk2(p[0], p[1024]); o0.y = pk2(p[2 * 1024], p[3 * 1024]); o0.z = pk2(p[4 * 1024], p[5 * 1024]); o0.w = pk2(p[6 * 1024], p[7 * 1024]);
        o1.x = pk2(p[8 * 1024], p[9 * 1024]); o1.y = pk2(p[10 * 1024], p[11 * 1024]); o1.z = pk2(p[12 * 1024], p[13 * 1024]); o1.w = pk2(p[14 * 1024], p[15 * 1024]);
        *(LAS v4u*)(wgt + n * 16) = o0; *(LAS v4u*)(wgt + n * 16 + 8) = o1; }
    __syncthreads();
    const bf16x8 zero8 = {0, 0, 0, 0, 0, 0, 0, 0};
    bf16x8 aw[8]; f32x4 bias[8];
#pragma unroll
    for (int q = 0; q < 8; ++q) { const int nt = 8 * w + q; aw[q] = (fq < 2) ? *(const LAS bf16x8*)(wgt + (16 * nt + fr) * 16 + 8 * fq) : zero8; bias[q] = *(const GAS f32x4*)(bg + 16 * nt + 4 * fq); }
    const int tile = w & 3, kh = w >> 2;
    for (int blk = blockIdx.x; blk < NTOK / 64; blk += F.G) {
        const size_t tok0 = (size_t)blk * 64 + tile * 16;
        f32x4 acc = {0.f, 0.f, 0.f, 0.f};
        const bf16* xr = xb + (tok0 + fr) * D + kh * 1024 + 8 * fq; const LAS bf16* wr = wzt + fr * WZP + kh * 1024 + 8 * fq;
#pragma unroll 8
        for (int ks = 0; ks < 32; ++ks) acc = MFMA16G(*(const GAS bf16x8*)(xr + 32 * ks), *(const LAS bf16x8*)(wr + 32 * ks), acc);
        if (kh == 1) *(LAS f32x4*)(zp + (tile * 64 + lane) * 4) = acc;
        __syncthreads();
        if (kh == 0) { acc = acc + *(const LAS f32x4*)(zp + (tile * 64 + lane) * 4);
#pragma unroll
            for (int i = 0; i < 4; ++i) zt[(tile * 16 + 4 * fq + i) * 16 + fr] = (bf16)(pk2(acc[i], 0.f) & 0xffffu); }
        __syncthreads();
#pragma unroll
        for (int t = 0; t < 4; ++t) { const bf16x8 bz = (fq < 2) ? *(const LAS bf16x8*)(zt + (t * 16 + fr) * 16 + 8 * fq) : zero8;
#pragma unroll
            for (int q = 0; q < 8; ++q) { f32x4 d = {0.f, 0.f, 0.f, 0.f}; d = MFMA16G(aw[q], bz, d);
                f32x4 o;
#pragma unroll
                for (int i = 0; i < 4; ++i) { const float a = d[i] + bias[q][i]; o[i] = (fminf(a, 0.f) - log1pf(__expf(-fabsf(a)))) * 0.0625f; }
                *(GAS f32x4*)(la + ((size_t)blk * 64 + t * 16 + fr) * 1024 + 16 * (8 * w + q) + 4 * fq) = o; } }
        __syncthreads();
    }
}

#define MFMA16(a, b, c) __builtin_amdgcn_mfma_f32_16x16x32_bf16((a), (b), (c), 0, 0, 0)
constexpr int GP = 264;
__device__ __forceinline__ void p2a_gla_pre(Frame& F) {
    LAS bf16* qd = (LAS bf16*)(F.lds + RING_OFF);
    LAS bf16* ki = qd + 64 * GP;
    LAS bf16* ke = ki + 64 * GP;
    LAS float* tot = (LAS float*)(ke + 64 * GP);
    const bf16* proj = WSP(bf16, WS_PROJ); const float* la = WSP(float, WS_LA);
    const int tid = F.tid, lane = F.lane, w = F.wave, fr = lane & 15, fq = lane >> 4;
    const int cseg = tid >> 6, t4 = (tid & 63) * 4;
    for (int it = blockIdx.x; it < NB * GH * 64; it += F.G) {
        const int b = it >> 8, h = (it >> 6) & 3, n = it & 63;
        const size_t row0 = (size_t)b * SEQ + n * 64;
        bf16* QD = WSP(bf16, WS_QD) + (size_t)it * 64 * 256; bf16* KET = WSP(bf16, WS_KET) + (size_t)it * 256 * 64;
        bf16* ATT = WSP(bf16, WS_ATTG) + (size_t)it * 64 * 64; float* DEC = WSP(float, WS_DEC) + (size_t)it * 256;
        f32x4 bc[8]; v2u rq[8], rk[8];
#pragma unroll
        for (int i = 0; i < 8; ++i) { const size_t r = row0 + 8 * cseg + i;
            bc[i] = *(const GAS f32x4*)(la + r * 1024 + h * 256 + t4);
            rq[i] = *(const GAS v2u*)(proj + r * NIN + h * 256 + t4); rk[i] = *(const GAS v2u*)(proj + r * NIN + 1024 + h * 256 + t4); }
#pragma unroll
        for (int i = 1; i < 8; ++i) bc[i] = bc[i] + bc[i - 1];
        *(LAS f32x4*)(tot + cseg * 256 + t4) = bc[7];
        __syncthreads();
        f32x4 pre = {0.f, 0.f, 0.f, 0.f}, blast = {0.f, 0.f, 0.f, 0.f};
#pragma unroll
        for (int sg = 0; sg < 8; ++sg) { const f32x4 tv = *(const LAS f32x4*)(tot + sg * 256 + t4); blast = blast + tv; if (sg < cseg) pre = pre + tv; }
        if (cseg == 0) { f32x4 d; d[0] = __expf(blast[0]); d[1] = __expf(blast[1]); d[2] = __expf(blast[2]); d[3] = __expf(blast[3]); *(GAS f32x4*)(DEC + t4) = d; }
#pragma unroll
        for (int i = 0; i < 8; ++i) { const int c = 8 * cseg + i; const f32x4 bb = bc[i] + pre;
            const float q0 = bflo(rq[i].x), q1 = bfhi(rq[i].x), q2 = bflo(rq[i].y), q3 = bfhi(rq[i].y), k0 = bflo(rk[i].x), k1 = bfhi(rk[i].x), k2 = bflo(rk[i].y), k3 = bfhi(rk[i].y);
            v2u oq, oi, oe;
            oq.x = pk2(q0 * __expf(bb[0]), q1 * __expf(bb[1])); oq.y = pk2(q2 * __expf(bb[2]), q3 * __expf(bb[3]));
            oi.x = pk2(k0 * __expf(-bb[0]), k1 * __expf(-bb[1])); oi.y = pk2(k2 * __expf(-bb[2]), k3 * __expf(-bb[3]));
            oe.x = pk2(k0 * __expf(blast[0] - bb[0]), k1 * __expf(blast[1] - bb[1])); oe.y = pk2(k2 * __expf(blast[2] - bb[2]), k3 * __expf(blast[3] - bb[3]));
            *(LAS v2u*)(qd + c * GP + t4) = oq; *(LAS v2u*)(ki + c * GP + t4) = oi; *(LAS v2u*)(ke + c * GP + t4) = oe;
            *(GAS v2u*)(QD + c * 256 + t4) = oq; }
        __syncthreads();
#pragma unroll
        for (int rep = 0; rep < 2; ++rep) { const int tl = w + 8 * rep, mi = tl >> 2, ni = tl & 3;
            f32x4 acc = {0.f, 0.f, 0.f, 0.f};
            if (ni <= mi) {
#pragma unroll
                for (int ks = 0; ks < 8; ++ks) { const bf16x8 af = *(const LAS bf16x8*)(qd + (16 * mi + fr) * GP + 32 * ks + 8 * fq), bfr = *(const LAS bf16x8*)(ki + (16 * ni + fr) * GP + 32 * ks + 8 * fq);
                    acc = MFMA16(af, bfr, acc); } }
#pragma unroll
            for (int i = 0; i < 4; ++i) { const int c = 16 * mi + 4 * fq + i, m = 16 * ni + fr; const float v = (m <= c) ? acc[i] : 0.f;
                ATT[c * 64 + m] = (bf16)(pk2(v, 0.f) & 0xffffu); } }
#pragma unroll
        for (int i = 0; i < 4; ++i) { const int G = (tid >> 4) + 32 * i, T0 = (G & 15) * 16, cg = G >> 4, li = lane & 15;
            const LAS bf16* kp = ke + (8 * cg + (li >> 2)) * GP + T0 + 4 * (li & 3);
            const s16x4 lo = __builtin_amdgcn_ds_read_tr16_b64_v4i16((LAS s16x4*)kp), hi4 = __builtin_amdgcn_ds_read_tr16_b64_v4i16((LAS s16x4*)(kp + 4 * GP));
            const bf16x8 o = {lo[0], lo[1], lo[2], lo[3], hi4[0], hi4[1], hi4[2], hi4[3]};
            *(GAS bf16x8*)(KET + (T0 + li) * 64 + 8 * cg) = o; }
        __syncthreads();
    }
}

constexpr int SC_VP = 40;
constexpr int SC_QD = 0, SC_AT = 64 * GP * 2, SC_VT = SC_AT + 64 * 72 * 2, SC_DEC = SC_VT + 64 * SC_VP * 2, SC_BUF = SC_DEC + 1024, SC_ST = 2 * SC_BUF;
static_assert(SC_ST + 2 * 32 * GP * 2 <= RING_BYTES, "scan LDS map");
struct ScanStage { v4u q0, q1, q2, q3, at, vt, dc; };
__device__ __forceinline__ void p2b_gla_scan(Frame& F) {
    LAS unsigned char* ring = F.lds + RING_OFF;
    bf16* og = WSP(bf16, WS_OGLA);
    const int tid = F.tid, lane = F.lane, w = F.wave, ql = lane & 31, hi = lane >> 5, fr = lane & 15, fq = lane >> 4, mi = w >> 1, ni = w & 1;
    for (int pass = 0; pass < 8; ++pass) {
        if (F.tid == 0) { const unsigned q = (xb_xcc_id() + (unsigned)pass) & 7u; const unsigned tk = __hip_atomic_fetch_add((unsigned*)(F.ctl + CW_SCANQ + 64 * q), 1u, __ATOMIC_RELAXED, __HIP_MEMORY_SCOPE_AGENT);
            F.MISC[16] = (tk < 32u) ? (q * 32u + tk) : 0xffffffffu; }
        __syncthreads();
        const int it = (int)__builtin_amdgcn_readfirstlane((int)F.MISC[16]);
        __syncthreads();
        if (it < 0) continue;
        pass = -1;
        const int b = it >> 6, h = (it >> 4) & 3, sl = it & 15;
        const size_t ci0 = (size_t)(b * 4 + h) * 64;
        const bf16* QDg = WSP(bf16, WS_QD) + ci0 * 64 * 256 + (size_t)tid * 8;
        const bf16* ATg = WSP(bf16, WS_ATTG) + ci0 * 64 * 64 + (size_t)tid * 8;
        const bf16* VTg = WSP(bf16, WS_PROJ) + ((size_t)b * SEQ + ((tid & 255) >> 2)) * NIN + 2048 + h * 512 + sl * 32 + (tid & 3) * 8;
        const float* DCg = WSP(float, WS_DEC) + ci0 * 256 + (size_t)(tid & 63) * 4;
        const bf16* KET = WSP(bf16, WS_KET) + ci0 * 256 * 64 + (32 * w + ql) * 64 + 8 * hi;
        const int vlS = ((8 * hi + ((lane & 15) >> 2)) * SC_VP + 16 * ((lane >> 4) & 1) + 4 * (lane & 3)) * 2, vlC = ((8 * fq + ((lane & 15) >> 2)) * SC_VP + 16 * ni + 4 * (lane & 3)) * 2;
        const int wq = ((tid >> 5) * GP + (tid & 31) * 8) * 2;
        const int wa = SC_AT + ((tid >> 3) * 72 + (tid & 7) * 8) * 2, wv = SC_VT + (((tid & 255) >> 2) * SC_VP + (tid & 3) * 8) * 2, wd = SC_DEC + (tid & 63) * 16;
#define SC_LOAD(st, n_) do { const size_t n1_ = (size_t)(n_); st.q0 = *(const GAS v4u*)(QDg + n1_ * 16384); st.q1 = *(const GAS v4u*)(QDg + n1_ * 16384 + 4096); st.q2 = *(const GAS v4u*)(QDg + n1_ * 16384 + 8192); \
        st.q3 = *(const GAS v4u*)(QDg + n1_ * 16384 + 12288); st.at = *(const GAS v4u*)(ATg + n1_ * 4096); if (tid < 256) st.vt = *(const GAS v4u*)(VTg + n1_ * (64 * NIN)); if (tid < 64) st.dc = *(const GAS v4u*)(DCg + n1_ * 256); } while (0)
#define SC_WRITE(st, bf) do { LAS unsigned char* d_ = ring + (bf) * SC_BUF; *(LAS v4u*)(d_ + wq) = st.q0; *(LAS v4u*)(d_ + wq + 16 * GP * 2) = st.q1; *(LAS v4u*)(d_ + wq + 32 * GP * 2) = st.q2; *(LAS v4u*)(d_ + wq + 48 * GP * 2) = st.q3; \
        *(LAS v4u*)(d_ + wa) = st.at; if (tid < 256) *(LAS v4u*)(d_ + wv) = st.vt; if (tid < 64) *(LAS v4u*)(d_ + wd) = st.dc; } while (0)
#define SC_KLOAD(ke, n_) do { _Pragma("unroll") for (int s_ = 0; s_ < 4; ++s_) ke[s_] = *(const GAS bf16x8*)(KET + (size_t)(n_) * 16384 + 16 * s_); } while (0)
        f32x16 S;
#pragma unroll
        for (int r = 0; r < 16; ++r) S[r] = 0.f;
        ScanStage sgA, sgB; bf16x8 keA[4], keB[4];
        sgA.vt = (v4u){0u, 0u, 0u, 0u}; sgA.dc = sgA.vt; sgB.vt = sgA.vt; sgB.dc = sgA.vt;
        SC_LOAD(sgA, 0); SC_WRITE(sgA, 0);
        SC_LOAD(sgA, 1); SC_LOAD(sgB, 2); SC_KLOAD(keA, 0); SC_KLOAD(keB, 1);
#define SC_STEP(n_, PAR, sg, ke) do { \
            LAS bf16* st_ = (LAS bf16*)(ring + SC_ST) + (PAR) * 32 * GP; const LAS unsigned char* cb_ = ring + (PAR) * SC_BUF; \
            _Pragma("unroll") for (int g_ = 0; g_ < 4; ++g_) { v2u o_; o_.x = pk2(S[4 * g_], S[4 * g_ + 1]); o_.y = pk2(S[4 * g_ + 2], S[4 * g_ + 3]); *(LAS v2u*)(st_ + ql * GP + 32 * w + 8 * g_ + 4 * hi) = o_; } \
            RAW_BAR(); \
            { f32x4 dec_[4]; bf16x8 vB_[4]; \
              _Pragma("unroll") for (int s_ = 0; s_ < 4; ++s_) { dec_[s_] = *(const LAS f32x4*)(cb_ + SC_DEC + (32 * w + 8 * s_ + 4 * hi) * 4); \
                  const s16x4 l_ = __builtin_amdgcn_ds_read_tr16_b64_v4i16((LAS s16x4*)(cb_ + SC_VT + vlS + (16 * s_) * SC_VP * 2)), h_ = __builtin_amdgcn_ds_read_tr16_b64_v4i16((LAS s16x4*)(cb_ + SC_VT + vlS + (16 * s_ + 4) * SC_VP * 2)); \
                  vB_[s_] = (bf16x8){l_[0], l_[1], l_[2], l_[3], h_[0], h_[1], h_[2], h_[3]}; } \
              _Pragma("unroll") for (int r_ = 0; r_ < 16; ++r_) S[r_] *= dec_[r_ >> 2][r_ & 3]; \
              _Pragma("unroll") for (int s_ = 0; s_ < 4; ++s_) S = MFMA32(ke[s_], vB_[s_], S); } \
            f32x4 o_ = {0.f, 0.f, 0.f, 0.f}; \
            _Pragma("unroll") for (int ks_ = 0; ks_ < 2; ++ks_) { const bf16x8 a_ = *(const LAS bf16x8*)(cb_ + SC_AT + ((16 * mi + fr) * 72 + 32 * ks_ + 8 * fq) * 2); \
                const s16x4 l_ = __builtin_amdgcn_ds_read_tr16_b64_v4i16((LAS s16x4*)(cb_ + SC_VT + vlC + (32 * ks_) * SC_VP * 2)), h_ = __builtin_amdgcn_ds_read_tr16_b64_v4i16((LAS s16x4*)(cb_ + SC_VT + vlC + (32 * ks_ + 4) * SC_VP * 2)); \
                const bf16x8 v_ = {l_[0], l_[1], l_[2], l_[3], h_[0], h_[1], h_[2], h_[3]}; o_ = MFMA16(a_, v_, o_); } \
            _Pragma("unroll") for (int ks_ = 0; ks_ < 8; ++ks_) { const bf16x8 a_ = *(const LAS bf16x8*)(cb_ + SC_QD + ((16 * mi + fr) * GP + 32 * ks_ + 8 * fq) * 2), sb_ = *(const LAS bf16x8*)(st_ + (16 * ni + fr) * GP + 32 * ks_ + 8 * fq); o_ = MFMA16(a_, sb_, o_); } \
            if ((n_) + 1 < 64) SC_WRITE(sg, 1 - (PAR)); \
            if ((n_) + 3 < 64) SC_LOAD(sg, (n_) + 3); \
            if ((n_) + 2 < 64) SC_KLOAD(ke, (n_) + 2); \
            { bf16* op_ = og + ((size_t)b * SEQ + (n_) * 64 + 16 * mi + 4 * fq) * D + h * 512 + sl * 32 + 16 * ni + fr; \
              _Pragma("unroll") for (int i_ = 0; i_ < 4; ++i_) op_[(size_t)i_ * D] = (bf16)(pk2(o_[i_], 0.f) & 0xffffu); } \
        } while (0)
        for (int n = 0; n < 64; n += 2) { SC_STEP(n, 0, sgA, keA); SC_STEP(n + 1, 1, sgB, keB); }
#undef SC_STEP
#undef SC_LOAD
#undef SC_WRITE
#undef SC_KLOAD
        __syncthreads();
    }
}

__device__ __forceinline__ void p3_rmsgate(Frame& F) {
    const bf16* og = WSP(bf16, WS_OGLA); const bf16* proj = WSP(bf16, WS_PROJ); bf16* a3 = WSP(bf16, WS_A3); const float* gn = F.in[4];
    const int gw = blockIdx.x * NWAVES + F.wave, NGW = F.G * NWAVES, lane = F.lane;
    for (int tok = gw; tok < NTOK; tok += NGW) {
        f32x4 v[8]; float ss[4];
#pragma unroll
        for (int j = 0; j < 8; ++j) { const v2u t_ = *(const GAS v2u*)(og + (size_t)tok * D + 4 * lane + 256 * j); v[j] = (f32x4){bflo(t_.x), bfhi(t_.x), bflo(t_.y), bfhi(t_.y)}; }
#pragma unroll
        for (int hh = 0; hh < 4; ++hh) { const f32x4 a = v[2 * hh], b = v[2 * hh + 1];
            float s = (a[0] * a[0] + a[1] * a[1]) + (a[2] * a[2] + a[3] * a[3]) + (b[0] * b[0] + b[1] * b[1]) + (b[2] * b[2] + b[3] * b[3]);
            ss[hh] = 1.0f / sqrtf(wave_sum(s) * (1.0f / 512.0f) + RMS_EPS); }
#pragma unroll
        for (int j = 0; j < 8; ++j) { const int col = 4 * lane + 256 * j;
            const v2u rr = *(const GAS v2u*)(proj + (size_t)tok * NIN + 4096 + col);
            const f32x4 g = *(const GAS f32x4*)(gn + (col & 511));
            const float sc = ss[j >> 1];
            const float o0 = v[j][0] * sc * g[0] * silu1(bflo(rr.x)), o1 = v[j][1] * sc * g[1] * silu1(bfhi(rr.x)), o2 = v[j][2] * sc * g[2] * silu1(bflo(rr.y)), o3 = v[j][3] * sc * g[3] * silu1(bfhi(rr.y));
            v2u o; o.x = pk2(o0, o1); o.y = pk2(o2, o3);
            *(GAS v2u*)(a3 + (size_t)tok * D + col) = o; }
    }
}

template <bool ROUTER> __device__ __forceinline__ void ln_phase(Frame& F, const bf16* T, const float* g, const float* bb, bf16* H) {
    const int gw = blockIdx.x * NWAVES + F.wave, NGW = F.G * NWAVES, lane = F.lane;
    for (int tok = gw; tok < NTOK; tok += NGW) {
        f32x4 v[8]; float s = 0.f;
#pragma unroll
        for (int j = 0; j < 8; ++j) { const v2u tq = *(const GAS v2u*)(T + (size_t)tok * D + 4 * lane + 256 * j); v[j] = (f32x4){bflo(tq.x), bfhi(tq.x), bflo(tq.y), bfhi(tq.y)}; s += (v[j][0] + v[j][1]) + (v[j][2] + v[j][3]); }
        const float mean = wave_sum(s) * (1.0f / D); float s2 = 0.f;
#pragma unroll
        for (int j = 0; j < 8; ++j) { v[j] = v[j] - mean; s2 += (v[j][0] * v[j][0] + v[j][1] * v[j][1]) + (v[j][2] * v[j][2] + v[j][3] * v[j][3]); }
        const float rstd = 1.0f / sqrtf(wave_sum(s2) * (1.0f / D) + LN_EPS);
        float lg[8];
#pragma unroll
        for (int e = 0; e < 8; ++e) lg[e] = 0.f;
#pragma unroll
        for (int j = 0; j < 8; ++j) { const int col = 4 * lane + 256 * j;
            const f32x4 gg = *(const GAS f32x4*)(g + col), bv = *(const GAS f32x4*)(bb + col);
            const f32x4 y = v[j] * rstd * gg + bv;
            v2u o; o.x = pk2(y[0], y[1]); o.y = pk2(y[2], y[3]);
            *(GAS v2u*)(H + (size_t)tok * D + col) = o;
            if (ROUTER) { const float* wr = F.in[13] + (size_t)col * 8;
#pragma unroll
                for (int c = 0; c < 4; ++c) { const f32x4 w0 = *(const GAS f32x4*)(wr + c * 8), w1 = *(const GAS f32x4*)(wr + c * 8 + 4);
                    lg[0] += y[c] * w0[0]; lg[1] += y[c] * w0[1]; lg[2] += y[c] * w0[2]; lg[3] += y[c] * w0[3];
                    lg[4] += y[c] * w1[0]; lg[5] += y[c] * w1[1]; lg[6] += y[c] * w1[2]; lg[7] += y[c] * w1[3]; } }
        }
        if (ROUTER) {
#pragma unroll
            for (int e = 0; e < 8; ++e) lg[e] = wave_sum(lg[e]);
            int i1 = 0; float v1 = lg[0];
#pragma unroll
            for (int e = 1; e < 8; ++e) if (lg[e] > v1) { v1 = lg[e]; i1 = e; }
            int i2 = -1; float v2 = -__builtin_inff();
#pragma unroll
            for (int e = 0; e < 8; ++e) if (e != i1 && lg[e] > v2) { v2 = lg[e]; i2 = e; }
            const float g1 = 1.0f / (1.0f + __expf(v2 - v1)), g2 = 1.0f - g1;
            if (lane == 0) {
                const unsigned r1 = __hip_atomic_fetch_add((unsigned*)(F.ctl + CW_CNT + 64 * i1), 1u, __ATOMIC_RELAXED, __HIP_MEMORY_SCOPE_AGENT);
                const unsigned r2 = __hip_atomic_fetch_add((unsigned*)(F.ctl + CW_CNT + 64 * i2), 1u, __ATOMIC_RELAXED, __HIP_MEMORY_SCOPE_AGENT);
                int* list = WSP(int, WS_LIST); list[(size_t)i1 * NTOK + r1] = tok; list[(size_t)i2 * NTOK + r2] = tok;
                v4u a; a.x = (unsigned)i1; a.y = r1; a.z = (unsigned)i2; a.w = r2; v4u b2; b2.x = __float_as_uint(g1); b2.y = __float_as_uint(g2); b2.z = 0u; b2.w = 0u;
                GAS v4u* ti = (GAS v4u*)(F.ws + WS_TOKINFO) + (size_t)tok * 2; ti[0] = a; ti[1] = b2; }
        }
    }
}

__device__ __forceinline__ void router_phase(Frame& F, const bf16* H) {
    const int gw = blockIdx.x * NWAVES + F.wave, NGW = F.G * NWAVES, lane = F.lane;
    for (int tok0 = gw * 4; tok0 < NTOK; tok0 += NGW * 4) {
        float lg[4][8];
#pragma unroll
        for (int t = 0; t < 4; ++t)
#pragma unroll
            for (int e = 0; e < 8; ++e) lg[t][e] = 0.f;
#pragma unroll 2
        for (int j = 0; j < 8; ++j) { const int col = 4 * lane + 256 * j;
            v2u hq[4];
#pragma unroll
            for (int t = 0; t < 4; ++t) hq[t] = *(const GAS v2u*)(H + (size_t)(tok0 + t) * D + col);
            const float* wr = F.in[13] + (size_t)col * 8;
#pragma unroll
            for (int c = 0; c < 4; ++c) { const f32x4 w0 = *(const GAS f32x4*)(wr + c * 8), w1 = *(const GAS f32x4*)(wr + c * 8 + 4);
#pragma unroll
                for (int t = 0; t < 4; ++t) { const unsigned hw = (c < 2) ? hq[t].x : hq[t].y; const float y = (c & 1) ? bfhi(hw) : bflo(hw);
                    lg[t][0] += y * w0[0]; lg[t][1] += y * w0[1]; lg[t][2] += y * w0[2]; lg[t][3] += y * w0[3];
                    lg[t][4] += y * w1[0]; lg[t][5] += y * w1[1]; lg[t][6] += y * w1[2]; lg[t][7] += y * w1[3]; } } }
#pragma unroll
        for (int t = 0; t < 4; ++t) {
#pragma unroll
            for (int e = 0; e < 8; ++e) lg[t][e] = wave_sum(lg[t][e]);
            int i1 = 0; float v1 = lg[t][0];
#pragma unroll
            for (int e = 1; e < 8; ++e) if (lg[t][e] > v1) { v1 = lg[t][e]; i1 = e; }
            int i2 = -1; float v2 = -__builtin_inff();
#pragma unroll
            for (int e = 0; e < 8; ++e) if (e != i1 && lg[t][e] > v2) { v2 = lg[t][e]; i2 = e; }
            const float g1 = 1.0f / (1.0f + __expf(v2 - v1)), g2 = 1.0f - g1;
            const int tok = tok0 + t; unsigned r1 = 0u, r2 = 0u;
            if (lane == 0) {
                r1 = __hip_atomic_fetch_add((unsigned*)(F.ctl + CW_CNT + 64 * i1), 1u, __ATOMIC_RELAXED, __HIP_MEMORY_SCOPE_AGENT);
                r2 = __hip_atomic_fetch_add((unsigned*)(F.ctl + CW_CNT + 64 * i2), 1u, __ATOMIC_RELAXED, __HIP_MEMORY_SCOPE_AGENT);
                v4u a; a.x = (unsigned)i1; a.y = r1; a.z = (unsigned)i2; a.w = r2; v4u b2; b2.x = __float_as_uint(g1); b2.y = __float_as_uint(g2); b2.z = 0u; b2.w = 0u;
                GAS v4u* ti = (GAS v4u*)(F.ws + WS_TOKINFO) + (size_t)tok * 2; ti[0] = a; ti[1] = b2; }
            r1 = (unsigned)__builtin_amdgcn_readfirstlane((int)r1); r2 = (unsigned)__builtin_amdgcn_readfirstlane((int)r2);
            unsigned char* x1 = WSP(unsigned char, WS_XG) + ((size_t)i1 * NTOK + r1) * D; unsigned char* x2 = WSP(unsigned char, WS_XG) + ((size_t)i2 * NTOK + r2) * D;
            { const GAS v4u* hp = (const GAS v4u*)(H + (size_t)tok * D + 32 * lane); v16f a0, a1;
#pragma unroll
              for (int c = 0; c < 2; ++c) { const v4u u = hp[c], v = hp[2 + c];
                  a0[8 * c + 0] = bflo(u.x); a0[8 * c + 1] = bfhi(u.x); a0[8 * c + 2] = bflo(u.y); a0[8 * c + 3] = bfhi(u.y); a0[8 * c + 4] = bflo(u.z); a0[8 * c + 5] = bfhi(u.z); a0[8 * c + 6] = bflo(u.w); a0[8 * c + 7] = bfhi(u.w);
                  a1[8 * c + 0] = bflo(v.x); a1[8 * c + 1] = bfhi(v.x); a1[8 * c + 2] = bflo(v.y); a1[8 * c + 3] = bfhi(v.y); a1[8 * c + 4] = bflo(v.z); a1[8 * c + 5] = bfhi(v.z); a1[8 * c + 6] = bflo(v.w); a1[8 * c + 7] = bfhi(v.w); }
              v4u p0, p1; mx6_record(a0, a1, p0, p1);
              const int ro = (lane >> 2) * 128 + (lane & 3) * 16;
              *(GAS v4u*)(x1 + ro) = p0; *(GAS v4u*)(x1 + ro + 64) = p1; *(GAS v4u*)(x2 + ro) = p0; *(GAS v4u*)(x2 + ro + 64) = p1; } }
    }
}

#define LOAD_CNT(cn) do { _Pragma("unroll") for (int _e = 0; _e < 8; ++_e) cn[_e] = (int)__hip_atomic_load((unsigned*)(F.ctl + CW_CNT + 64 * _e), __ATOMIC_RELAXED, __HIP_MEMORY_SCOPE_AGENT); } while (0)

__device__ __forceinline__ void p14_gather(Frame& F) {
    int cn[8]; LOAD_CNT(cn);
    const int gw = blockIdx.x * NWAVES + F.wave, NGW = F.G * NWAVES, lane = F.lane;
    int total = 0;
#pragma unroll
    for (int e = 0; e < 8; ++e) total += (cn[e] + 255) >> 8;
    const bf16* h3 = WSP(bf16, WS_H3); unsigned char* xg = WSP(unsigned char, WS_XG); const int* list = WSP(int, WS_LIST);
    for (int p = gw; p < total * 256; p += NGW) {
        int e = 0, off = 0, cnt = 0, acc = 0; bool found = false;
#pragma unroll
        for (int k = 0; k < 8; ++k) { const int te = ((cn[k] + 255) >> 8) * 256; if (!found && p < acc + te) { found = true; e = k; off = acc; cnt = cn[k]; } acc += te; }
        const int r = p - off;
        GAS v4u* dst = (GAS v4u*)(xg + (size_t)p * D) + lane;
        if (r < cnt) { const int tok = list[(size_t)e * NTOK + r]; const GAS v4u* src = (const GAS v4u*)(h3 + (size_t)tok * D) + 2 * lane;
#pragma unroll
            for (int j = 0; j < 2; ++j) { const v4u a = src[128 * j], b2 = src[128 * j + 1]; v4u o;
                o.x = pk4f8(bflo(a.x) * XSC, bfhi(a.x) * XSC, bflo(a.y) * XSC, bfhi(a.y) * XSC); o.y = pk4f8(bflo(a.z) * XSC, bfhi(a.z) * XSC, bflo(a.w) * XSC, bfhi(a.w) * XSC);
                o.z = pk4f8(bflo(b2.x) * XSC, bfhi(b2.x) * XSC, bflo(b2.y) * XSC, bfhi(b2.y) * XSC); o.w = pk4f8(bflo(b2.z) * XSC, bfhi(b2.z) * XSC, bflo(b2.w) * XSC, bfhi(b2.w) * XSC);
                dst[64 * j] = o; } }
        else { const v4u zz = {0u, 0u, 0u, 0u};
#pragma unroll
            for (int j = 0; j < 2; ++j) dst[64 * j] = zz; }
    }
}

__device__ __forceinline__ int build_moe_table(Frame& F, int NT, int wgm, bool sparse_a) {
    int cn[8]; LOAD_CNT(cn);
    int U = 0;
#pragma unroll
    for (int e = 0; e < 8; ++e) U += ((cn[e] + 255) >> 8) * NT;
    LAS int* tab = (LAS int*)(F.lds + TAB_OFF);
    const int c = blockIdx.x, G = F.G;
    if (F.tid < 64) { const long L = (long)F.tid * G + c;
        if (L < U) { int wgid = (int)L; { const int q = U / 8, r = U % 8, xcd = wgid % 8, off = wgid / 8; wgid = (xcd < r ? xcd * (q + 1) : r * (q + 1) + (xcd - r) * q) + off; }
            int e = 0, tb = 0, tiles = 1, rem = wgid, tp = 0; bool found = false;
#pragma unroll
            for (int k = 0; k < 8; ++k) { const int te = (cn[k] + 255) >> 8, ue = te * NT; if (!found) { if (rem < ue) { found = true; e = k; tiles = te; tb = tp; } else { rem -= ue; tp += te; } } }
            const int nig = wgm * NT, gid = rem / nig, fm = gid * wgm, gsz = (tiles - fm) < wgm ? (tiles - fm) : wgm;
            const int lt = fm + ((rem % nig) % gsz); tab[3 * F.tid] = sparse_a ? e * (NTOK / 256) + lt : tb + lt; tab[3 * F.tid + 1] = e * NT + (rem % nig) / gsz; tab[3 * F.tid + 2] = tb + lt; } }
    __syncthreads();
    return (U > c) ? (U - c + G - 1) / G : 0;
}

__device__ __forceinline__ void p17_final(Frame& F) {
    int cn[8]; LOAD_CNT(cn);
    const int gw = blockIdx.x * NWAVES + F.wave, NGW = F.G * NWAVES, lane = F.lane;
    const bf16* h3 = WSP(bf16, WS_H3); const unsigned char* Y = WSP(unsigned char, WS_Y); const float* g = F.in[16] + D; const float* bb = F.in[17] + D; float* out = F.out;
    for (int tok = gw; tok < NTOK; tok += NGW) {
        const GAS v4u* ti = (const GAS v4u*)(F.ws + WS_TOKINFO) + (size_t)tok * 2; const v4u a = ti[0], b2 = ti[1];
        int o1 = 0, o2 = 0, acc = 0;
#pragma unroll
        for (int k = 0; k < 8; ++k) { if ((int)a.x == k) o1 = acc; if ((int)a.z == k) o2 = acc; acc += ((cn[k] + 255) >> 8) * 256; }
        const size_t p1 = (size_t)(o1 + (int)a.y), p2 = (size_t)(o2 + (int)a.w); const float g1 = __uint_as_float(b2.x) * (1.0f / YSC), g2 = __uint_as_float(b2.y) * (1.0f / YSC);
        f32x4 v[8]; float s = 0.f;
#pragma unroll
        for (int j = 0; j < 8; ++j) { const int col = 4 * lane + 256 * j;
            const v2u hh = *(const GAS v2u*)(h3 + (size_t)tok * D + col); const int y1 = *(const GAS int*)(Y + p1 * D + col), y2 = *(const GAS int*)(Y + p2 * D + col);
            const auto a01 = __builtin_amdgcn_cvt_pk_f32_fp8(y1, false), a23 = __builtin_amdgcn_cvt_pk_f32_fp8(y1, true), b01 = __builtin_amdgcn_cvt_pk_f32_fp8(y2, false), b23 = __builtin_amdgcn_cvt_pk_f32_fp8(y2, true);
            v[j][0] = ALPHA * bflo(hh.x) + g1 * a01[0] + g2 * b01[0]; v[j][1] = ALPHA * bfhi(hh.x) + g1 * a01[1] + g2 * b01[1];
            v[j][2] = ALPHA * bflo(hh.y) + g1 * a23[0] + g2 * b23[0]; v[j][3] = ALPHA * bfhi(hh.y) + g1 * a23[1] + g2 * b23[1];
            s += (v[j][0] + v[j][1]) + (v[j][2] + v[j][3]); }
        const float mean = wave_sum(s) * (1.0f / D); float s2 = 0.f;
#pragma unroll
        for (int j = 0; j < 8; ++j) { v[j] = v[j] - mean; s2 += (v[j][0] * v[j][0] + v[j][1] * v[j][1]) + (v[j][2] * v[j][2] + v[j][3] * v[j][3]); }
        const float rstd = 1.0f / sqrtf(wave_sum(s2) * (1.0f / D) + LN_EPS);
#pragma unroll
        for (int j = 0; j < 8; ++j) { const int col = 4 * lane + 256 * j;
            const f32x4 gg = *(const GAS f32x4*)(g + col), bv = *(const GAS f32x4*)(bb + col);
            *(GAS f32x4*)(out + (size_t)tok * D + col) = v[j] * rstd * gg + bv; }
    }
}

__device__ __forceinline__ unsigned f8byte(float x) { return (unsigned)__builtin_amdgcn_cvt_pk_fp8_f32(x, x, 0, false) & 0xffu; }
__device__ __forceinline__ void p10_kmean(Frame& F) {
    LAS float* red = (LAS float*)(F.lds + RING_OFF);
    const bf16* kvq = WSP(bf16, WS_KVQ); float* km = WSP(float, WS_KM);
    const int d = F.tid & 127, q4 = F.tid >> 7;
    for (int it = blockIdx.x; it < NB * MKV * NBLK; it += F.G) {
        const int b = it >> 6, g = (it >> 4) & 3, j = it & 15;
        const bf16* base = kvq + ((size_t)b * SEQ + j * 256 + q4 * 64) * NKVQ + g * 128 + d; float s = 0.f;
        unsigned char* k8 = WSP(unsigned char, WS_K8) + (((size_t)(b * 4 + g) * SEQ + j * 256 + q4 * 64) * 128) + d;
#pragma unroll 8
        for (int r = 0; r < 64; ++r) { const float kv = bf1(base[(size_t)r * NKVQ]); s += kv; k8[r * 128] = (unsigned char)f8byte(kv); }
        v4u vo[4];
#pragma unroll
        for (int c = 0; c < 4; ++c) { unsigned w4[4];
#pragma unroll
            for (int m = 0; m < 4; ++m) { float x[4];
#pragma unroll
                for (int e = 0; e < 4; ++e) { const int sl = 16 * c + 4 * m + e, hi = sl >> 5, jj = sl & 31, r = jj & 15, key = (jj >> 4) * 32 + (r & 3) + 8 * (r >> 2) + 4 * hi;
                    x[e] = bf1(base[(size_t)key * NKVQ + 512]); }
                w4[m] = pk4f8(x[0], x[1], x[2], x[3]); }
            vo[c] = (v4u){w4[0], w4[1], w4[2], w4[3]}; }
        GAS v4u* v8 = (GAS v4u*)(WSP(unsigned char, WS_V8T) + ((((size_t)(b * 4 + g) * 64 + j * 4 + q4) * 128 + d) * 64));
#pragma unroll
        for (int c = 0; c < 4; ++c) v8[c] = vo[c];
        red[q4 * 128 + d] = s;
        __syncthreads();
        if (F.tid < 128) km[(size_t)it * 128 + d] = (red[d] + red[128 + d] + red[256 + d] + red[384 + d]) * (1.0f / 256.0f);
        __syncthreads();
    }
}
#ifndef WGM_P1
#define WGM_P1 4
#endif
#ifndef WGM_N8
#define WGM_N8 4
#endif
#ifndef WGM_GU
#define WGM_GU 4
#endif
#ifndef WGM_DD
#define WGM_DD 4
#endif
#ifndef WGM_KVQ
#define WGM_KVQ 4
#endif
#ifndef WGM_MGU
#define WGM_MGU 8
#endif
#ifndef WGM_MDN
#define WGM_MDN 8
#endif
#ifndef REPMASK
#define REPMASK 0u
#endif

constexpr float AT_THR = 3.0f;
__device__ __forceinline__ float max3f(float a, float b, float c) { float r; asm("v_max3_f32 %0, %1, %2, %3" : "=v"(r) : "v"(a), "v"(b), "v"(c)); return r; }
typedef int v8i __attribute__((ext_vector_type(8)));
#define MFMA8(a, b, c, sa, sb) __builtin_amdgcn_mfma_scale_f32_32x32x64_f8f6f4((a), (b), (c), 0, 0, 0, (sa), 0, (sb))
constexpr int A8_KP = 144, A8_VP = 80, A8_KSZ = 64 * A8_KP, A8_VSZ = 128 * A8_VP, A8_GATE = 2 * A8_KSZ + 2 * A8_VSZ, AT_GP = 136;
constexpr int CV_ITEMS = NE * (D / 64) * (2 * FE / 32), CV_LDS = 49152;
__device__ __forceinline__ void cv_issue(const Frame& F, int r, LAS unsigned char* img, int lane, int h) {
    const int r2 = r >> 1, e = r2 / 7168, rr = r2 % 7168, kb64 = 2 * (rr / 448) + (r & 1), nb = rr % 448, pn = nb >> 3, qn = nb & 7, half = qn >> 2, cg = qn & 3;
    const GAS char* src = (const GAS char*)(F.in[14] + (size_t)e * D * 2 * FE + (size_t)(64 * kb64) * (2 * FE) + half * FE + pn * 128 + cg * 32);
    const unsigned lo = (unsigned)(((lane >> 3) * (2 * FE) + 4 * (lane & 7)) * 4);
    const GAS char* p = src + lo + (size_t)h * 32 * (2 * FE) * 4;
    img += h * 4096;
#pragma unroll
    for (int i = 0; i < 4; ++i) { __builtin_amdgcn_global_load_lds((const unsigned*)p, (LAS unsigned*)(img + i * 1024), 16, 0, 0); p += (size_t)8 * (2 * FE) * 4; asm volatile("" : "+v"(p)); }
}
__device__ __forceinline__ void cv_finish(const Frame& F, int r, const LAS unsigned char* img, int lane) {
    const int r2 = r >> 1, e = r2 / 7168, rr = r2 % 7168, kb64 = 2 * (rr / 448) + (r & 1), nb = rr % 448;
    const int n = lane & 31, q = lane >> 5;
    const LAS float* s = (const LAS float*)img + (32 * q) * 32 + n;
    v16f x0, x1;
#pragma unroll
    for (int i = 0; i < 16; ++i) { x0[i] = s[i * 32]; x1[i] = s[(16 + i) * 32]; }
    v4u p0, p1; mx6_record(x0, x1, p0, p1);
    unsigned char* o = F.ws + WS_W_GUM + ((size_t)e * 2 * FE + 32 * nb + n) * (size_t)D + 128 * (kb64 >> 1) + 32 * (kb64 & 1) + 16 * q;
    *(GAS v4u*)o = p0; *(GAS v4u*)(o + 64) = p1;
}
__device__ __forceinline__ void p11_attn(Frame& F, int it0, int it1) {
    LAS unsigned char* base = F.lds + RING_OFF;
    const bf16* kvq = WSP(bf16, WS_KVQ); const float* km = WSP(float, WS_KM);
    const int tid = F.tid, lane = F.lane, w = F.wave, ql = lane & 31, hi = lane >> 5;
    const int kwoff = (tid >> 3) * A8_KP + (tid & 7) * 16, vwoff = (tid >> 2) * A8_VP + (tid & 3) * 16;
    const int kroff = ql * A8_KP + 32 * hi, vroff = ql * A8_VP + 32 * hi;
    const float NEG = -__builtin_inff();
    constexpr float L2E = 1.4426950408889634f;
    constexpr int SC1 = 0x7F7F7F7F, SC16 = 0x7B7B7B7B;
    LAS unsigned char* const cvimg = base + CV_LDS + __builtin_amdgcn_readfirstlane(w) * 8192;
    const int cvgw = (int)blockIdx.x * NWAVES + __builtin_amdgcn_readfirstlane(w), cvstep = F.G * NWAVES;
    int cvr = 2 * cvgw, cvp = -1;
    int cvr0 = 2 * (int)blockIdx.x * NWAVES, cvp0 = -1;
    int cvh = 0, cvh0 = 0;
#define CV_WAIT() do { if (cvh == 2) asm volatile("s_waitcnt vmcnt(0)" ::: "memory"); } while (0)
#define CV_HOOK() do { if (cvh == 2) { cv_finish(F, cvp, cvimg, lane); asm volatile("s_waitcnt lgkmcnt(0)" ::: "memory"); cvp = -1; cvh = 0; } \
        if (cvh == 1) { cv_issue(F, cvp, cvimg, lane, 1); cvh = 2; } \
        else if (cvr < CV_ITEMS) { cv_issue(F, cvr, cvimg, lane, 0); cvp = cvr; cvh = 1; cvr = (cvr & 1) ? cvr - 1 + 2 * cvstep : cvr + 1; } \
        if (cvh0 == 2) { cvp0 = -1; cvh0 = 0; } \
        if (cvh0 == 1) cvh0 = 2; else if (cvr0 < CV_ITEMS) { cvp0 = cvr0; cvh0 = 1; cvr0 = (cvr0 & 1) ? cvr0 - 1 + 2 * cvstep : cvr0 + 1; } } while (0)
    for (int id0 = blockIdx.x + it0 * F.G; id0 < NB * MH * NBLK && id0 < (int)blockIdx.x + it1 * F.G; id0 += F.G) {
        const int id = (F.G == 256) ? ((id0 & ~255) | ((id0 & 7) << 5) | ((id0 & 255) >> 3)) : id0;
        const int rr = id >> 8, q4 = (id >> 6) & 3, bh = id & 63;
        const int n = rr == 0 ? q4 : rr == 1 ? 7 - q4 : rr == 2 ? 8 + q4 : 15 - q4;
        const int b = bh >> 4, h = bh & 15, g = h >> 2;
        const size_t qrow0 = (size_t)b * SEQ + n * 256 + w * 32;
        int lo_ = (int)__builtin_amdgcn_mbcnt_hi(~0u, __builtin_amdgcn_mbcnt_lo(~0u, 0u)), to_ = __builtin_amdgcn_readfirstlane(w) * 64 + lo_; asm volatile("" : "+v"(lo_), "+v"(to_));
        const int skey = to_ >> 4, sdc = (to_ & 15) * 8;
        const unsigned qoff = (unsigned)((lo_ & 31) * NKVQ + (lo_ >> 5) * 8) * 2u, kmoff = (unsigned)((to_ >> 4) * 128 + (to_ & 15) * 8) * 4u;
        const GAS char* qb = (const GAS char*)(kvq + qrow0 * NKVQ + 1024 + h * 128);
        unsigned mask = 0u;
        { bf16x8 qf[8];
#pragma unroll
          for (int st = 0; st < 8; ++st) qf[st] = *(const GAS bf16x8*)(qb + qoff + st * 32);
          { v4u o = {0u, 0u, 0u, 0u};
            if (skey < 16) { const GAS char* kp = (const GAS char*)(km + (size_t)(b * 4 + g) * 16 * 128) + kmoff; const f32x4 a = *(const GAS f32x4*)kp, c = *(const GAS f32x4*)(kp + 16);
                o.x = pk2(a[0], a[1]); o.y = pk2(a[2], a[3]); o.z = pk2(c[0], c[1]); o.w = pk2(c[2], c[3]); }
            *(LAS v4u*)((LAS bf16*)(base + A8_GATE) + skey * AT_GP + sdc) = o; }
          __syncthreads();
          f32x16 s;
#pragma unroll
          for (int r = 0; r < 16; ++r) s[r] = 0.f;
#pragma unroll
          for (int st = 0; st < 8; ++st) { const bf16x8 kf = *(const LAS bf16x8*)((LAS bf16*)(base + A8_GATE) + ql * AT_GP + st * 16 + hi * 8); s = MFMA32(kf, qf[st], s); }
          float sc[16];
#pragma unroll
          for (int jj = 0; jj < 16; ++jj) { const int a = jj >> 3, c = (jj >> 2) & 1, i = jj & 3; const float own = s[4 * a + i]; const float oth = __shfl_xor(own, 32);
              sc[jj] = (hi == c) ? own : oth; if (jj >= n) sc[jj] = NEG; }
#pragma unroll
          for (int j = 0; j < 16; ++j) { int cnt = 0;
#pragma unroll
              for (int j2 = 0; j2 < 16; ++j2) if (j2 != j) cnt += ((sc[j2] > sc[j]) || (sc[j2] == sc[j] && j2 < j)) ? 1 : 0;
              if (cnt < 3 && j < n) mask |= (1u << j); } }
        v8i q8[2];
#pragma unroll
        for (int st = 0; st < 2; ++st) { const GAS char* qp = (const GAS char*)(kvq + qrow0 * NKVQ + 1024 + h * 128) + (unsigned)((lo_ & 31) * NKVQ + 64 * st + 32 * (lo_ >> 5)) * 2u;
#pragma unroll
            for (int c = 0; c < 4; ++c) { const v4u x = *(const GAS v4u*)(qp + 16 * c);
                q8[st][2 * c] = (int)pk4f8(bflo(x.x) * 16.f, bfhi(x.x) * 16.f, bflo(x.y) * 16.f, bfhi(x.y) * 16.f); q8[st][2 * c + 1] = (int)pk4f8(bflo(x.z) * 16.f, bfhi(x.z) * 16.f, bflo(x.w) * 16.f, bfhi(x.w) * 16.f); } }
        float m_run = -1e30f, l_run = 0.f; f32x16 o[4];
#pragma unroll
        for (int dt = 0; dt < 4; ++dt)
#pragma unroll
            for (int r = 0; r < 16; ++r) o[dt][r] = 0.f;
        const int NP = 4 * n;
        const GAS char* k8b = (const GAS char*)(WSP(unsigned char, WS_K8) + (size_t)(b * 4 + g) * SEQ * 128) + (unsigned)to_ * 16u;
        const GAS char* v8b = (const GAS char*)(WSP(unsigned char, WS_V8T) + (size_t)(b * 4 + g) * 64 * 8192) + (unsigned)to_ * 16u;
        v4u rk, rv;
        LAS unsigned char* const kring = base; LAS unsigned char* const vring = base + 2 * A8_KSZ;
#define AT_LOADK(tt) do { rk = *(const GAS v4u*)(k8b + (size_t)(tt) * 8192); } while (0)
#define AT_LOADV(tt) do { rv = *(const GAS v4u*)(v8b + (size_t)(tt) * 8192); } while (0)
#define AT_WRITEK(bf) do { *(LAS v4u*)(kring + (bf) * A8_KSZ + kwoff) = rk; } while (0)
#define AT_WRITEV(bf) do { *(LAS v4u*)(vring + (bf) * A8_VSZ + vwoff) = rv; } while (0)
#define AT_QK(bf, S0, S1) do { const LAS unsigned char* kp_ = kring + (bf) * A8_KSZ + kroff; \
            _Pragma("unroll") for (int r_ = 0; r_ < 16; ++r_) { S0[r_] = 0.f; S1[r_] = 0.f; } \
            _Pragma("unroll") for (int st_ = 0; st_ < 2; ++st_) { \
                const v4u a0_ = *(const LAS v4u*)(kp_ + 64 * st_), a1_ = *(const LAS v4u*)(kp_ + 64 * st_ + 16), b0_ = *(const LAS v4u*)(kp_ + 32 * A8_KP + 64 * st_), b1_ = *(const LAS v4u*)(kp_ + 32 * A8_KP + 64 * st_ + 16); \
                const v8i ka_ = {(int)a0_.x, (int)a0_.y, (int)a0_.z, (int)a0_.w, (int)a1_.x, (int)a1_.y, (int)a1_.z, (int)a1_.w}, kb_ = {(int)b0_.x, (int)b0_.y, (int)b0_.z, (int)b0_.w, (int)b1_.x, (int)b1_.y, (int)b1_.z, (int)b1_.w}; \
                S0 = MFMA8(ka_, q8[st_], S0, SC1, SC16); S1 = MFMA8(kb_, q8[st_], S1, SC1, SC16); } } while (0)
#define AT_SMPV(S0, S1, ROWOK, VB) do { \
            float mxa_ = max3f(S0[0], S0[1], S0[2]), mxb_ = max3f(S1[0], S1[1], S1[2]); \
            _Pragma("unroll") for (int r_ = 3; r_ < 15; r_ += 2) { mxa_ = max3f(mxa_, S0[r_], S0[r_ + 1]); mxb_ = max3f(mxb_, S1[r_], S1[r_ + 1]); } \
            float mx_ = max3f(mxa_, mxb_, S0[15]); mx_ = max3f(mx_, S1[15], S1[15]); \
            { const float o_ = __shfl_xor(mx_, 32); mx_ = max3f(mx_, o_, o_); } \
            const bool upd_ = (ROWOK) && (mx_ > m_run + AT_THR); \
            if (__any(upd_ ? 1 : 0)) { const float mn_ = upd_ ? mx_ : m_run, al_ = __builtin_amdgcn_exp2f((m_run - mn_) * L2E); l_run *= al_; m_run = mn_; \
                _Pragma("unroll") for (int dt_ = 0; dt_ < 4; ++dt_) o[dt_] = o[dt_] * al_; } \
            const float mb_ = (ROWOK) ? 4.0f - m_run * L2E : NEG;     \
            S0 = S0 * L2E + mb_; S1 = S1 * L2E + mb_; \
            _Pragma("unroll") for (int r_ = 0; r_ < 16; ++r_) { S0[r_] = __builtin_amdgcn_exp2f(S0[r_]); S1[r_] = __builtin_amdgcn_exp2f(S1[r_]); } \
            { const f32x16 t_ = S0 + S1; const float ps_ = ((t_[0] + t_[1]) + (t_[2] + t_[3])) + ((t_[4] + t_[5]) + (t_[6] + t_[7])) + ((t_[8] + t_[9]) + (t_[10] + t_[11])) + ((t_[12] + t_[13]) + (t_[14] + t_[15])); \
              l_run += ps_; } \
            v8i pf_; \
            _Pragma("unroll") for (int m_ = 0; m_ < 4; ++m_) { pf_[m_] = (int)pk4f8(S0[4 * m_], S0[4 * m_ + 1], S0[4 * m_ + 2], S0[4 * m_ + 3]); \
                pf_[4 + m_] = (int)pk4f8(S1[4 * m_], S1[4 * m_ + 1], S1[4 * m_ + 2], S1[4 * m_ + 3]); } \
            const LAS unsigned char* vb_ = (VB) + vroff; \
            _Pragma("unroll") for (int dt_ = 0; dt_ < 4; ++dt_) { const v4u a0_ = *(const LAS v4u*)(vb_ + 32 * dt_ * A8_VP), a1_ = *(const LAS v4u*)(vb_ + 32 * dt_ * A8_VP + 16); \
                const v8i va_ = {(int)a0_.x, (int)a0_.y, (int)a0_.z, (int)a0_.w, (int)a1_.x, (int)a1_.y, (int)a1_.z, (int)a1_.w}; \
                o[dt_] = MFMA8(va_, pf_, o[dt_], SC1, SC16); } } while (0)
        __syncthreads();
        if (NP > 0) {
            AT_LOADK(0); AT_LOADV(0); AT_WRITEK(0); AT_WRITEV(0);
            AT_LOADK(1); AT_WRITEK(1);
            RAW_BAR();
            f32x16 c0, c1, n0, n1;
            AT_QK(0, c0, c1);
            AT_LOADK(2); AT_LOADV(1);
            RAW_BAR();
#define AT_STEP(tt_, C0, C1, N0, N1) do { const bool ok_ = ((mask >> ((tt_) >> 2)) & 1u) != 0u; \
                AT_QK(((tt_) + 1) & 1, N0, N1); \
                AT_SMPV(C0, C1, ok_, vring + ((tt_) & 1) * A8_VSZ); \
                AT_WRITEK((tt_) & 1); AT_WRITEV(((tt_) + 1) & 1); \
                CV_WAIT(); \
                { const int tk_ = ((tt_) + 3 < NP) ? (tt_) + 3 : NP - 1, tv_ = ((tt_) + 2 < NP) ? (tt_) + 2 : NP - 1; AT_LOADK(tk_); AT_LOADV(tv_); } \
                RAW_BAR(); \
                __builtin_amdgcn_sched_barrier(0); CV_HOOK(); __builtin_amdgcn_sched_barrier(0); } while (0)
            for (int tt = 0; tt < NP; tt += 2) { AT_STEP(tt, c0, c1, n0, n1); AT_STEP(tt + 1, n0, n1, c0, c1); }
#undef AT_STEP
        }
        { AT_LOADK(NP); AT_LOADV(NP); AT_WRITEK(0); AT_WRITEV(0); AT_LOADK(NP + 1); AT_LOADV(NP + 1);
          RAW_BAR();
          for (int kt = 0; kt < 4; ++kt) {
              if (kt <= (w >> 1)) {
                  f32x16 s0, s1; AT_QK(kt & 1, s0, s1);
                  if (kt == (w >> 1)) { const int qpos = 32 * w + ql - 64 * kt;
#pragma unroll
                      for (int r = 0; r < 16; ++r) { const int key = (r & 3) + 8 * (r >> 2) + 4 * hi; if (key > qpos) s0[r] = NEG; if (key + 32 > qpos) s1[r] = NEG; } }
                  AT_SMPV(s0, s1, true, vring + (kt & 1) * A8_VSZ);
              }
              if (kt + 1 < 4) { AT_WRITEK((kt + 1) & 1); AT_WRITEV((kt + 1) & 1); }
              if (kt + 2 < 4) { AT_LOADK(NP + kt + 2); AT_LOADV(NP + kt + 2); }
              RAW_BAR();
          } }
#undef AT_LOADK
#undef AT_LOADV
#undef AT_WRITEK
#undef AT_WRITEV
#undef AT_QK
#undef AT_SMPV
        int lo2_ = (int)__builtin_amdgcn_mbcnt_hi(~0u, __builtin_amdgcn_mbcnt_lo(~0u, 0u)); asm volatile("" : "+v"(lo2_));
        const unsigned ooff = (unsigned)((lo2_ & 31) * D + 4 * (lo2_ >> 5)) * 2u;
        const float lt = l_run + __shfl_xor(l_run, 32), inv = 16.0f * OSC / lt;
        unsigned char* a8 = WSP(unsigned char, WS_A3) + qrow0 * D + h * 128;
#pragma unroll
        for (int dt = 0; dt < 4; ++dt)
#pragma unroll
            for (int g4 = 0; g4 < 4; ++g4) *(GAS unsigned*)(a8 + (ooff >> 1) + dt * 32 + 8 * g4) = pk4f8(o[dt][4 * g4] * inv, o[dt][4 * g4 + 1] * inv, o[dt][4 * g4 + 2] * inv, o[dt][4 * g4 + 3] * inv);
    }
    while (cvp0 >= 0 || cvr0 < CV_ITEMS) { CV_WAIT(); RAW_BAR(); CV_HOOK(); }
#undef CV_HOOK
#undef CV_WAIT
}

struct Args { const float* in[18]; float* out; unsigned char* ws; int ph_lo, ph_hi; };
__global__ void __launch_bounds__(NWAVES * 64, 2) mk_fwd(Args args) {
    extern __shared__ __attribute__((aligned(16))) unsigned char lds[];
    Frame F;
    F.lds = (LAS unsigned char*)lds;
    F.MISC = (volatile LAS unsigned*)(F.lds + MISC_OFF);
    F.tid = threadIdx.x; F.lane = F.tid & 63; F.wave = __builtin_amdgcn_readfirstlane(F.tid >> 6);
    F.G = gridDim.x; F.ws = args.ws; F.out = args.out;
#pragma unroll
    for (int i = 0; i < 18; ++i) F.in[i] = args.in[i];
    F.ctl = (gu32*)(args.ws + WS_CTL);
    for (int u = F.tid; u < (LDS_BYTES - LDSCTL_OFF) / 4; u += NWAVES * 64) ((LAS unsigned*)(F.lds + LDSCTL_OFF))[u] = 0u;
    __syncthreads();
    XcdBarrier bar; bar.bar = (unsigned*)(F.ctl + CW_BAR); bar.x = 0; bar.st = nullptr;
    if (MK_ONE_LAUNCH) bar = xcd_barrier_post((unsigned*)(F.ctl + CW_BAR), F.MISC + 8);
    const int lo = args.ph_lo, hi = args.ph_hi;
#define IN(k) (lo <= (k) && (k) < hi)
#define SEAM(k) do { if (IN(k) && IN((k) + 1)) { xcd_barrier(bar); if (REPMASK & 0x80000000u) { xcd_barrier(bar); xcd_barrier(bar); } } } while (0)
    if (F.tid == 0) { const unsigned xcc = xb_xcc_id(); const unsigned rk = __hip_atomic_fetch_add((unsigned*)(F.ctl + CW_XRANK + 64 * (xcc & 7u)), 1u, __ATOMIC_RELAXED, __HIP_MEMORY_SCOPE_AGENT); F.MISC[20] = rk * 8u + (xcc & 7u); }
    int bx = (int)blockIdx.x;

#define PHASE(k, ...) do { if (IN(k)) { __VA_ARGS__ if ((REPMASK >> (k)) & 1u) { __syncthreads(); __VA_ARGS__ } } SEAM(k); } while (0)
    PHASE(0, p0_prologue<0>(F););
    if (IN(0) && IN(1) && F.G == 256) { bool ok = true;
#pragma unroll
        for (int j = 0; j < 8; ++j) ok = ok && (__hip_atomic_load((unsigned*)(F.ctl + CW_XRANK + 64 * j), __ATOMIC_RELAXED, __HIP_MEMORY_SCOPE_AGENT) == 32u);
        if (ok) bx = (int)__builtin_amdgcn_readfirstlane((int)F.MISC[20]); }
    PHASE(1,
        { pg8::Gemm g{WSP(pg8::bf16_t, WS_XB), WSP(pg8::bf16_t, WS_W_IN), NTOK, NIN, D}; pg8::StaticOrder S; S.init(NTOK, NIN, F.G, bx, WGM_P1);
        pg8::EpiBf16Plain E{WSP(pg8::bf16_t, WS_PROJ), NIN, NIN / 256, 1.0f};
        pg8::gemm_phase<pg8::EpiBf16Plain, pg8::StaticOrder, PG8_ALIGN, PG8_SP2>(F.lds + RING_OFF, g, S, E);
        p1_gate(F); if (REPMASK & 0x40000000u) p1_gate(F); });
    PHASE(2, p2a_gla_pre(F););
    PHASE(3, p2b_gla_scan(F););
    PHASE(4, p3_rmsgate(F););
    PHASE(5,
        { pg8::Gemm g{WSP(pg8::bf16_t, WS_A3), WSP(pg8::bf16_t, WS_W_OA), NTOK, D, D}; pg8::StaticOrder S; S.init(NTOK, D, F.G, bx, WGM_N8);
        pg8::EpiLnFused<false> E{WSP(pg8::bf16_t, WS_H1), (const void*)F.in[0], D, ALPHA, F.in[9], F.in[10], WSP(unsigned long long, WS_SLOTS), (unsigned*)(F.ctl + CW_PANEL), (unsigned*)(F.ctl + CW_TMO), F.lds + LNTAB_OFF};
        pg8::gemm_phase<pg8::EpiLnFused<false>, pg8::StaticOrder, true, PG8_SP2>(F.lds + RING_OFF, g, S, E); });
    static_assert(WGM_N8 * 8 <= 32 && WGM_DD * 8 <= 32, "fused LayerNorm epilogues: the 8 column tiles of a row panel must run in the same round (one 32-unit group per XCD round)");
    PHASE(7,
        { pg8::Gemm g{WSP(pg8::bf16_t, WS_H1), WSP(pg8::bf16_t, WS_W_GUD), NTOK, 2 * FD, D}; pg8::StaticOrder S; S.init(NTOK, 2 * FD, F.G, bx, WGM_GU);
        pg8::EpiSwiglu E{WSP(pg8::bf16_t, WS_ACT), FD, 2 * FD / 256};
        pg8::gemm_phase<pg8::EpiSwiglu, pg8::StaticOrder, PG8_ALIGN, PG8_SP2>(F.lds + RING_OFF, g, S, E); });
    PHASE(8,
        { pg8::Gemm g{WSP(pg8::bf16_t, WS_ACT), WSP(pg8::bf16_t, WS_W_DD), NTOK, D, FD}; pg8::StaticOrder S; S.init(NTOK, D, F.G, bx, WGM_DD);
        pg8::EpiLnFused<true> E{WSP(pg8::bf16_t, WS_H2), (const void*)WSP(bf16, WS_H1), D, ALPHA, F.in[16], F.in[17], WSP(unsigned long long, WS_SLOTS) + (size_t)NTOK * 8, (unsigned*)(F.ctl + CW_PANEL + 64 * 64), (unsigned*)(F.ctl + CW_TMO), F.lds + LNTAB_OFF};
        pg8::gemm_phase<pg8::EpiLnFused<true>, pg8::StaticOrder, true, PG8_SP2>(F.lds + RING_OFF, g, S, E); });
    PHASE(10,
        { pg8::Gemm g{WSP(pg8::bf16_t, WS_H2), WSP(pg8::bf16_t, WS_W_KVQ), NTOK, NKVQ, D}; pg8::StaticOrder S; S.init(NTOK, NKVQ, F.G, bx, WGM_KVQ);
        pg8::EpiBf16Plain E{WSP(pg8::bf16_t, WS_KVQ), NKVQ, NKVQ / 256, 1.0f};
        pg8::gemm_phase<pg8::EpiBf16Plain, pg8::StaticOrder, PG8_ALIGN, PG8_SP2>(F.lds + RING_OFF, g, S, E); });
    PHASE(11, p10_kmean(F););
    PHASE(12, p11_attn(F, 0, 1 << 20););
    { int l_ = (int)__builtin_amdgcn_mbcnt_hi(~0u, __builtin_amdgcn_mbcnt_lo(~0u, 0u)); asm volatile("" : "+v"(l_)); F.lane = l_; F.tid = F.wave * 64 + l_; }
    PHASE(13,
        { pg8::Gemm g{WSP(pg8::bf16_t, WS_A3), WSP(pg8::bf16_t, WS_W_OB), NTOK, D, D / 2, 0x78787878, 0x7A7A7A7A}; pg8::StaticOrder S; S.init(NTOK, D, F.G, bx, WGM_N8);
        pg8::EpiLnFused<true> E{WSP(pg8::bf16_t, WS_H3), (const void*)WSP(bf16, WS_H2), D, ALPHA, F.in[9] + D, F.in[10] + D, WSP(unsigned long long, WS_SLOTS) + (size_t)2 * NTOK * 8, (unsigned*)(F.ctl + CW_PANEL + 2 * 64 * 64), (unsigned*)(F.ctl + CW_TMO), F.lds + LNTAB_OFF};
        pg8::gemm_phase<pg8::EpiLnFused<true>, pg8::StaticOrder, true, PG8_SP2, true>(F.lds + RING_OFF, g, S, E); });
    static_assert(((REPMASK >> 14) & 1u) == 0u, "the routing phase counts with atomics: not repeatable");
    #ifndef CONV_REP
#define CONV_REP 0
#endif
    PHASE(14, router_phase(F, WSP(bf16, WS_H3)););
    PHASE(16,
        { const int nu = build_moe_table(F, 2 * FE / 256, WGM_MGU, true);
        pg8::Gemm g{WSP(pg8::bf16_t, WS_XG), WSP(pg8::bf16_t, WS_W_GUM), NE * NTOK, NE * 2 * FE, D / 2};
        const int t0 = ((const LAS int*)(F.lds + TAB_OFF))[3 * F.lane], t1 = ((const LAS int*)(F.lds + TAB_OFF))[3 * F.lane + 1], t2 = ((const LAS int*)(F.lds + TAB_OFF))[3 * F.lane + 2];
        pg8::EpiSwigluF8 E{WSP(unsigned char, WS_ACTM), FE, 2 * FE / 256, ASC};
        int kc = 1 + 3 * ((blockIdx.x >> 3) & 7); kc = kc < nu ? kc : nu;
        { pg8::TableOrder S{t0, t1, t2, kc, 0}; pg8::gemm_phase<pg8::EpiSwigluF8, pg8::TableOrder, PG8_ALIGN, PG8_SP2, 2>(F.lds + RING_OFF, g, S, E); }
        __syncthreads(); p0_expert<2>(F); __syncthreads();
        { pg8::TableOrder S{t0, t1, t2, nu, kc}; pg8::gemm_phase<pg8::EpiSwigluF8, pg8::TableOrder, PG8_ALIGN, PG8_SP2, 2>(F.lds + RING_OFF, g, S, E); } });
    PHASE(17,
        { const int nu = build_moe_table(F, D / 256, WGM_MDN, false);
        pg8::Gemm g{WSP(pg8::bf16_t, WS_ACTM), WSP(pg8::bf16_t, WS_W_DM), XG_ROWS, NE * D, FE / 2, 0x77777777, 0x7D7D7D7D};
        pg8::TableOrder S{((const LAS int*)(F.lds + TAB_OFF))[3 * F.lane], ((const LAS int*)(F.lds + TAB_OFF))[3 * F.lane + 1], ((const LAS int*)(F.lds + TAB_OFF))[3 * F.lane + 2], nu};
        pg8::EpiF8Plain E{WSP(unsigned char, WS_Y), D, D / 256, YSC};
        pg8::gemm_phase<pg8::EpiF8Plain, pg8::TableOrder, PG8_ALIGN, PG8_SP2, true>(F.lds + RING_OFF, g, S, E); });
    PHASE(18, p17_final(F););
#undef PHASE
#undef IN
#undef SEAM
}

extern "C" void kernel_launch(void* const* d_in, const int* in_sizes, int n_in, void* d_out, int out_size, void* d_ws, size_t ws_size, hipStream_t stream) {
    static int grid = 0;
    if (grid == 0) {
        if (n_in != 18 || out_size != NTOK * D || ws_size < WS_END) { fprintf(stderr, "kernel_launch: unexpected shapes (n_in %d out %d ws %zu need %zu)\n", n_in, out_size, ws_size, (size_t)WS_END); grid = -1; return; }
        int dev = 0, cus = 0, per_cu = 0;
        if (hipGetDevice(&dev) != hipSuccess || hipDeviceGetAttribute(&cus, hipDeviceAttributeMultiprocessorCount, dev) != hipSuccess) { grid = -1; return; }
        if (hipFuncSetAttribute((const void*)mk_fwd, hipFuncAttributeMaxDynamicSharedMemorySize, LDS_BYTES) != hipSuccess) { fprintf(stderr, "kernel_launch: hipFuncSetAttribute failed\n"); grid = -1; return; }
        if (hipOccupancyMaxActiveBlocksPerMultiprocessor(&per_cu, (const void*)mk_fwd, NWAVES * 64, LDS_BYTES) != hipSuccess || per_cu < 1) { fprintf(stderr, "kernel_launch: occupancy query says %d\n", per_cu); }
        (void)hipGetLastError();
        grid = cus;
    }
    if (grid < 0) return;
    (void)hipMemsetAsync((char*)d_ws + WS_CTL, 0, CTL_ZERO_BYTES, stream);
    Args a{};
    for (int i = 0; i < 18; ++i) a.in[i] = (const float*)d_in[i];
    a.out = (float*)d_out; a.ws = (unsigned char*)d_ws;
    if (MK_ONE_LAUNCH) { a.ph_lo = 0; a.ph_hi = NPH; hipLaunchKernelGGL(mk_fwd, dim3(grid), dim3(NWAVES * 64), LDS_BYTES, stream, a); }
    else for (int p = 0; p < NPH; ++p) { a.ph_lo = p; a.ph_hi = p + 1; hipLaunchKernelGGL(mk_fwd, dim3(grid), dim3(NWAVES * 64), LDS_BYTES, stream, a); }
}
```

```cpp
#include <hip/hip_runtime.h>
#include <cstdio>
#include <cstdint>
namespace pg8 {
#define PG8_LAS __attribute__((address_space(3)))
typedef unsigned short bf16_t;
typedef short bf16x8 __attribute__((ext_vector_type(8)));
typedef float f32x4 __attribute__((ext_vector_type(4)));
typedef unsigned u32x4 __attribute__((ext_vector_type(4)));
constexpr int BM = 256, BK = 64, HALF = 128, HTB = HALF * BK * 2  , STAGE_BYTES = 8 * HTB, NXCD = 8, WGM = 8;

__host__ __device__ __forceinline__ int lds_byte(int r, int c) { const int st = (r >> 4) * 2 + (c >> 5), rr = r & 15, cc = c & 31, ob = rr * 64 + cc * 2; return st * 1024 + (ob ^ (((ob >> 9) & 1) << 5)); }
__host__ __device__ __forceinline__ void stage_rc(int b, int& R, int& C) { const int st = b / 1024, sb = b % 1024, swz = sb ^ (((sb >> 9) & 1) << 5); R = (st >> 1) * 16 + swz / 64; C = (st & 1) * 32 + (swz % 64) / 2; }
__host__ __device__ __forceinline__ int perm32(int rho) { const int n = rho >> 4, i = rho & 15; return 8 * (i >> 2) + 4 * n + (i & 3); }

struct Unit { int pm, pn, po; };
struct Gemm { const bf16_t* A; const bf16_t* Bt; int M, N, K; int scw = 0x7F7F7F7F, sca = 0x7F7F7F7F; };

struct StaticOrder {
    int nM, nN, nwg, G, c, wgm;
    __host__ __device__ void init(int M, int N, int G_, int c_, int wgm_ = WGM) { nM = M / BM; nN = N / BM; nwg = nM * nN; G = G_; c = c_; wgm = wgm_; }
    __host__ __device__ bool next(int i, Unit& u) const {
        const long L = (long)i * G + c; if (L >= nwg) return false;
        int wgid = (int)L; { const int q = nwg / NXCD, r = nwg % NXCD, xcd = wgid % NXCD, off = wgid / NXCD; wgid = (xcd < r ? xcd * (q + 1) : r * (q + 1) + (xcd - r) * q) + off; }
        const int nig = wgm * nN, gid = wgid / nig, fm = gid * wgm, gsz = (nM - fm) < wgm ? (nM - fm) : wgm;
        u.pm = fm + ((wgid % nig) % gsz); u.pn = (wgid % nig) / gsz; u.po = u.pm; return true;
    }
    __device__ __forceinline__ void a_ready(const Unit&) const {}
    __device__ __forceinline__ void done(const Unit&) const {}
};
__device__ __forceinline__ unsigned cvt_pk_bf16(float lo, float hi) { unsigned r; asm volatile("v_cvt_pk_bf16_f32 %0, %1, %2" : "=v"(r) : "v"(lo), "v"(hi)); return r; }

struct EpiBf16Plain {
    static constexpr bool PERM = true, AFTER_DRAIN = false;
    bf16_t* O; int ldc; int ntn; float scale;
    __device__ __forceinline__ void operator()(const f32x4 (&acc)[2][2][4][2], const Unit& u, int wr, int wc, int fr, int fq) const {
        const int row0 = u.pm * BM + wr * 64 + fr; const int col0 = (u.pn % ntn) * BM + wc * 32 + 8 * fq;
#pragma unroll
        for (int ai = 0; ai < 2; ++ai)
#pragma unroll
            for (int m = 0; m < 4; ++m) { bf16_t* rowp = O + (size_t)(row0 + ai * HALF + m * 16) * ldc + col0;
#pragma unroll
                for (int bj = 0; bj < 2; ++bj) { const f32x4 v0 = acc[ai][bj][m][0] * scale, v1 = acc[ai][bj][m][1] * scale;
                    u32x4 w; w.x = cvt_pk_bf16(v0[0], v0[1]); w.y = cvt_pk_bf16(v0[2], v0[3]); w.z = cvt_pk_bf16(v1[0], v1[1]); w.w = cvt_pk_bf16(v1[2], v1[3]);
                    *(u32x4*)(rowp + bj * HALF) = w; } }
    }
};
__device__ __forceinline__ float silu_f(float x) { return x * __builtin_amdgcn_rcpf(1.0f + __builtin_amdgcn_exp2f(-1.4426950408889634f * x)); }
struct EpiSwiglu {
    static constexpr bool PERM = true, AFTER_DRAIN = false;
    bf16_t* O; int ldc; int ntn;
    __device__ __forceinline__ void operator()(const f32x4 (&acc)[2][2][4][2], const Unit& u, int wr, int wc, int fr, int fq) const {
        const int row0 = u.pm * BM + wr * 64 + fr; const int col0 = (u.pn % ntn) * HALF + wc * 32 + 8 * fq;
#pragma unroll
        for (int ai = 0; ai < 2; ++ai)
#pragma unroll
            for (int m = 0; m < 4; ++m) { bf16_t* rowp = O + (size_t)(row0 + ai * HALF + m * 16) * ldc + col0;
                const f32x4 g0 = acc[ai][0][m][0], g1 = acc[ai][0][m][1], u0 = acc[ai][1][m][0], u1 = acc[ai][1][m][1];
                u32x4 w;
                w.x = cvt_pk_bf16(silu_f(g0[0]) * u0[0], silu_f(g0[1]) * u0[1]); w.y = cvt_pk_bf16(silu_f(g0[2]) * u0[2], silu_f(g0[3]) * u0[3]);
                w.z = cvt_pk_bf16(silu_f(g1[0]) * u1[0], silu_f(g1[1]) * u1[1]); w.w = cvt_pk_bf16(silu_f(g1[2]) * u1[2], silu_f(g1[3]) * u1[3]);
                *(u32x4*)rowp = w; }
    }
};
__device__ __forceinline__ unsigned pk4_fp8(float a, float b, float c, float d) {
    a = __builtin_amdgcn_fmed3f(a, -448.f, 448.f); b = __builtin_amdgcn_fmed3f(b, -448.f, 448.f); c = __builtin_amdgcn_fmed3f(c, -448.f, 448.f); d = __builtin_amdgcn_fmed3f(d, -448.f, 448.f);
    int r = __builtin_amdgcn_cvt_pk_fp8_f32(a, b, 0, false); r = __builtin_amdgcn_cvt_pk_fp8_f32(c, d, r, true); return (unsigned)r; }
struct EpiF8Plain {
    static constexpr bool PERM = true, AFTER_DRAIN = false;
    unsigned char* O; int ldc; int ntn; float scale;
    __device__ __forceinline__ void operator()(const f32x4 (&acc)[2][2][4][2], const Unit& u, int wr, int wc, int fr, int fq) const {
        const int row0 = u.po * BM + wr * 64 + fr; const int col0 = (u.pn % ntn) * BM + wc * 32 + 8 * fq;
#pragma unroll
        for (int ai = 0; ai < 2; ++ai)
#pragma unroll
            for (int m = 0; m < 4; ++m) { unsigned char* rowp = O + (size_t)(row0 + ai * HALF + m * 16) * ldc + col0;
#pragma unroll
                for (int bj = 0; bj < 2; ++bj) { const f32x4 v0 = acc[ai][bj][m][0] * scale, v1 = acc[ai][bj][m][1] * scale;
                    const unsigned lo = pk4_fp8(v0[0], v0[1], v0[2], v0[3]), hi = pk4_fp8(v1[0], v1[1], v1[2], v1[3]);
                    *(unsigned long long*)(rowp + bj * HALF) = (unsigned long long)lo | ((unsigned long long)hi << 32); } }
    }
};
struct EpiSwigluF8 {
    static constexpr bool PERM = true, AFTER_DRAIN = false;
    unsigned char* O; int ldc; int ntn; float sout;
    __device__ __forceinline__ void operator()(const f32x4 (&acc)[2][2][4][2], const Unit& u, int wr, int wc, int fr, int fq) const {
        const int row0 = u.po * BM + wr * 64 + fr; const int col0 = (u.pn % ntn) * HALF + wc * 32 + 8 * fq;
#pragma unroll
        for (int ai = 0; ai < 2; ++ai)
#pragma unroll
            for (int m = 0; m < 4; ++m) { unsigned char* rowp = O + (size_t)(row0 + ai * HALF + m * 16) * ldc + col0;
                const f32x4 g0 = acc[ai][0][m][0], g1 = acc[ai][0][m][1], u0 = acc[ai][1][m][0] * sout, u1 = acc[ai][1][m][1] * sout;
                unsigned lo = pk4_fp8(silu_f(g0[0]) * u0[0], silu_f(g0[1]) * u0[1], silu_f(g0[2]) * u0[2], silu_f(g0[3]) * u0[3]);
                unsigned hi = pk4_fp8(silu_f(g1[0]) * u1[0], silu_f(g1[1]) * u1[1], silu_f(g1[2]) * u1[2], silu_f(g1[3]) * u1[3]);
                *(unsigned long long*)rowp = (unsigned long long)lo | ((unsigned long long)hi << 32); }
    }
};
template <bool RES_BF16> struct EpiResBf16 {
    static constexpr bool PERM = true, AFTER_DRAIN = false;
    bf16_t* T; const void* res; int ldc; float alpha;
    __device__ __forceinline__ void operator()(const f32x4 (&acc)[2][2][4][2], const Unit& u, int wr, int wc, int fr, int fq) const {
        const int row0 = u.pm * BM + wr * 64 + fr, col0 = u.pn * BM + wc * 32 + 8 * fq;
#pragma unroll
        for (int ai = 0; ai < 2; ++ai)
#pragma unroll
            for (int m = 0; m < 4; ++m) { const size_t ro = (size_t)(row0 + ai * HALF + m * 16) * ldc + col0;
#pragma unroll
                for (int bj = 0; bj < 2; ++bj) { const size_t o = ro + bj * HALF; f32x4 r0, r1;
                    if (RES_BF16) { const u32x4 q = *(const u32x4*)((const bf16_t*)res + o);
                        r0[0] = __uint_as_float(q.x << 16); r0[1] = __uint_as_float(q.x & 0xffff0000u); r0[2] = __uint_as_float(q.y << 16); r0[3] = __uint_as_float(q.y & 0xffff0000u);
                        r1[0] = __uint_as_float(q.z << 16); r1[1] = __uint_as_float(q.z & 0xffff0000u); r1[2] = __uint_as_float(q.w << 16); r1[3] = __uint_as_float(q.w & 0xffff0000u); }
                    else { r0 = *(const f32x4*)((const float*)res + o); r1 = *(const f32x4*)((const float*)res + o + 4); }
                    const f32x4 v0 = r0 * alpha + acc[ai][bj][m][0], v1 = r1 * alpha + acc[ai][bj][m][1];
                    u32x4 w; w.x = cvt_pk_bf16(v0[0], v0[1]); w.y = cvt_pk_bf16(v0[2], v0[3]); w.z = cvt_pk_bf16(v1[0], v1[1]); w.w = cvt_pk_bf16(v1[2], v1[3]);
                    *(u32x4*)(T + o) = w; } }
    }
};
template <bool RES_BF16> struct EpiLnFused {
    static constexpr bool PERM = true, AFTER_DRAIN = false;
    bf16_t* H; const void* res; int ldc; float alpha; const float* g; const float* b;
    unsigned long long* slots;
    unsigned* cnt;
    unsigned* tmo;
    PG8_LAS unsigned char* tab;
    __device__ __forceinline__ void operator()(const f32x4 (&acc)[2][2][4][2], const Unit& u, int wr, int wc, int fr, int fq) const {
        typedef float f2 __attribute__((ext_vector_type(2)));
        PG8_LAS f2* P = (PG8_LAS f2*)tab; PG8_LAS f2* S = (PG8_LAS f2*)(tab + 8192);
        const int tid = threadIdx.x, lane = tid & 63;
        const int row0 = u.pm * BM + wr * 64 + fr, col0 = u.pn * BM + wc * 32 + 8 * fq;
        f32x4 t[2][4][2][2];
#pragma unroll
        for (int ai = 0; ai < 2; ++ai)
#pragma unroll
            for (int m = 0; m < 4; ++m) { const size_t ro = (size_t)(row0 + ai * HALF + m * 16) * ldc + col0; float s = 0.f, q = 0.f;
#pragma unroll
                for (int bj = 0; bj < 2; ++bj) { const size_t o = ro + bj * HALF; f32x4 r0, r1;
                    if (RES_BF16) { const u32x4 w = *(const u32x4*)((const bf16_t*)res + o);
                        r0[0] = __uint_as_float(w.x << 16); r0[1] = __uint_as_float(w.x & 0xffff0000u); r0[2] = __uint_as_float(w.y << 16); r0[3] = __uint_as_float(w.y & 0xffff0000u);
                        r1[0] = __uint_as_float(w.z << 16); r1[1] = __uint_as_float(w.z & 0xffff0000u); r1[2] = __uint_as_float(w.w << 16); r1[3] = __uint_as_float(w.w & 0xffff0000u); }
                    else { r0 = *(const f32x4*)((const float*)res + o); r1 = *(const f32x4*)((const float*)res + o + 4); }
                    const f32x4 v0 = r0 * alpha + acc[ai][bj][m][0], v1 = r1 * alpha + acc[ai][bj][m][1];
                    t[ai][m][bj][0] = v0; t[ai][m][bj][1] = v1;
                    s += ((v0[0] + v0[1]) + (v0[2] + v0[3])) + ((v1[0] + v1[1]) + (v1[2] + v1[3]));
                    q += ((v0[0] * v0[0] + v0[1] * v0[1]) + (v0[2] * v0[2] + v0[3] * v0[3])) + ((v1[0] * v1[0] + v1[1] * v1[1]) + (v1[2] * v1[2] + v1[3] * v1[3])); }
                s += __shfl_xor(s, 16); s += __shfl_xor(s, 32); q += __shfl_xor(q, 16); q += __shfl_xor(q, 32);
                if (fq == 0) P[(ai * HALF + wr * 64 + m * 16 + fr) * 4 + wc] = (f2){s, q}; }
        asm volatile("s_waitcnt lgkmcnt(0)" ::: "memory"); __builtin_amdgcn_s_barrier(); asm volatile("" ::: "memory");
        if (tid < 256) { const f2 a = P[tid * 4 + 0], b2 = P[tid * 4 + 1], c = P[tid * 4 + 2], d = P[tid * 4 + 3];
            const float ts = (a.x + b2.x) + (c.x + d.x), tq = (a.y + b2.y) + (c.y + d.y);
            __hip_atomic_store(slots + ((size_t)u.pm * BM + tid) * 8 + u.pn, ((unsigned long long)__float_as_uint(tq) << 32) | (unsigned long long)__float_as_uint(ts), __ATOMIC_RELAXED, __HIP_MEMORY_SCOPE_AGENT);
            asm volatile("s_waitcnt vmcnt(0)" ::: "memory");
            if (lane == 0) __hip_atomic_fetch_add(cnt + 64 * u.pm, 1u, __ATOMIC_RELAXED, __HIP_MEMORY_SCOPE_AGENT); }
        if (tid < 64) { unsigned sp = 0;
            while ((unsigned)__builtin_amdgcn_readfirstlane(__hip_atomic_load(cnt + 64 * u.pm, __ATOMIC_RELAXED, __HIP_MEMORY_SCOPE_AGENT)) < 32u) {
                __builtin_amdgcn_s_sleep(2);
                if ((++sp & 255u) == 0u) { if (__hip_atomic_load(tmo, __ATOMIC_RELAXED, __HIP_MEMORY_SCOPE_AGENT) != 0u) break; if (sp > (1u << 20)) { if (tid == 0) __hip_atomic_store(tmo, 1u, __ATOMIC_RELAXED, __HIP_MEMORY_SCOPE_AGENT); break; } } }
            __builtin_amdgcn_fence(__ATOMIC_ACQUIRE, "agent"); asm volatile("s_waitcnt vmcnt(0)" ::: "memory"); }
        asm volatile("" ::: "memory"); __builtin_amdgcn_s_barrier(); asm volatile("" ::: "memory");
        if (tid < 256) { float ts = 0.f, tq = 0.f;
#pragma unroll
            for (int k = 0; k < 8; ++k) { const unsigned long long x = __hip_atomic_load(slots + ((size_t)u.pm * BM + tid) * 8 + k, __ATOMIC_RELAXED, __HIP_MEMORY_SCOPE_AGENT); ts += __uint_as_float((unsigned)x); tq += __uint_as_float((unsigned)(x >> 32)); }
            const float mean = ts * (1.0f / 2048.0f), var = tq * (1.0f / 2048.0f) - mean * mean;
            S[tid] = (f2){mean, 1.0f / sqrtf(fmaxf(var, 0.f) + 1e-5f)}; }
        asm volatile("s_waitcnt lgkmcnt(0)" ::: "memory"); __builtin_amdgcn_s_barrier(); asm volatile("" ::: "memory");
        f32x4 gv[2][2], bv[2][2];
#pragma unroll
        for (int bj = 0; bj < 2; ++bj)
#pragma unroll
            for (int n = 0; n < 2; ++n) { gv[bj][n] = *(const f32x4*)(g + col0 + bj * HALF + 4 * n); bv[bj][n] = *(const f32x4*)(b + col0 + bj * HALF + 4 * n); }
#pragma unroll
        for (int ai = 0; ai < 2; ++ai)
#pragma unroll
            for (int m = 0; m < 4; ++m) { const f2 st = S[ai * HALF + wr * 64 + m * 16 + fr]; bf16_t* rowp = H + (size_t)(row0 + ai * HALF + m * 16) * ldc + col0;
#pragma unroll
                for (int bj = 0; bj < 2; ++bj) { const f32x4 v0 = (t[ai][m][bj][0] - st.x) * st.y * gv[bj][0] + bv[bj][0], v1 = (t[ai][m][bj][1] - st.x) * st.y * gv[bj][1] + bv[bj][1];
                    u32x4 w; w.x = cvt_pk_bf16(v0[0], v0[1]); w.y = cvt_pk_bf16(v0[2], v0[3]); w.z = cvt_pk_bf16(v1[0], v1[1]); w.w = cvt_pk_bf16(v1[2], v1[3]);
                    *(u32x4*)(rowp + bj * HALF) = w; } }
    }
};
struct TableOrder {
    int pmv, pnv, pov; int n; int i0 = 0;
    __device__ __forceinline__ bool next(int i, Unit& u) const { i += i0; if (i >= n) return false; u.pm = __builtin_amdgcn_readlane(pmv, i); u.pn = __builtin_amdgcn_readlane(pnv, i); u.po = __builtin_amdgcn_readlane(pov, i); return true; }
    __device__ __forceinline__ void a_ready(const Unit&) const {}
    __device__ __forceinline__ void done(const Unit&) const {}
};
typedef int v4i_t __attribute__((ext_vector_type(4)));
typedef int v8i_t __attribute__((ext_vector_type(8)));
template <int F8> __device__ __forceinline__ void mma_blk(f32x4 (&acc)[4][2], const bf16x8 (&At)[4][2], const bf16x8 (&Bt)[2][2], int scw, int sca) {
    if constexpr (!F8) {
#pragma unroll
        for (int m = 0; m < 4; ++m)
#pragma unroll
            for (int n = 0; n < 2; ++n)
#pragma unroll
                for (int k = 0; k < 2; ++k) acc[m][n] = __builtin_amdgcn_mfma_f32_16x16x32_bf16(Bt[n][k], At[m][k], acc[m][n], 0, 0, 0);
    } else {
#pragma unroll
        for (int m = 0; m < 4; ++m)
#pragma unroll
            for (int n = 0; n < 2; ++n) {
                const v8i_t a = __builtin_shufflevector(__builtin_bit_cast(v4i_t, Bt[n][0]), __builtin_bit_cast(v4i_t, Bt[n][1]), 0, 1, 2, 3, 4, 5, 6, 7);
                const v8i_t b = __builtin_shufflevector(__builtin_bit_cast(v4i_t, At[m][0]), __builtin_bit_cast(v4i_t, At[m][1]), 0, 1, 2, 3, 4, 5, 6, 7);
                if constexpr (F8 == 1) asm volatile("v_mfma_scale_f32_16x16x128_f8f6f4 %0, %1, %2, %0, %3, %4 op_sel_hi:[0,0,0]" : "+v"(acc[m][n]) : "v"(a), "v"(b), "v"(scw), "v"(sca));
                else { typedef int v6i_t __attribute__((ext_vector_type(6)));
                    const v6i_t a6 = __builtin_shufflevector(a, a, 0, 1, 2, 3, 4, 5), b6 = __builtin_shufflevector(b, b, 0, 1, 2, 3, 4, 5);
                    asm volatile("s_nop 1\n\tv_mfma_scale_f32_16x16x128_f8f6f4 %0, %1, %2, %0, %3, %4 op_sel_hi:[0,0,0] cbsz:2 blgp:2" : "+v"(acc[m][n]) : "v"(a6), "v"(b6), "v"(a[6]), "v"(b[6])); } }
    }
}
template <class Epi, class Sched, bool ALIGN_EPI = false, bool SP2 = false, int F8 = 0>
__device__ __forceinline__ void gemm_phase(PG8_LAS unsigned char* lds, const Gemm g, const Sched& S, const Epi& E) {
    const int tid = threadIdx.x, wid = __builtin_amdgcn_readfirstlane(tid >> 6), lane = tid & 63, wr = wid >> 2, wc = wid & 3, fr = lane & 15, fq = lane >> 4;
    const int K = g.K, nt = K / BK;
    unsigned voffA[2], voffB[2];
#pragma unroll
    for (int i = 0; i < 2; ++i) { int R, C; stage_rc(tid * 16 + i * 8192, R, C); const int Rb = Epi::PERM ? ((R & ~31) + perm32(R & 31)) : R;
        voffA[i] = (unsigned)(R * K + C) * 2u; voffB[i] = (unsigned)(Rb * K + C) * 2u; }
    const size_t kstep = (size_t)(BK * 2);
    const size_t hstep = (size_t)HALF * K * 2;
    const size_t tstep = 2 * hstep;
    const unsigned ldsw = (unsigned)wid * 1024u;
    const int aoff = lds_byte(wr * 64 + fr, fq * 8), boff = lds_byte(wc * 32 + fr, fq * 8);
#define PG8_SA(b, h) (((b) * 2 + (h)) * HTB)
#define PG8_SB(b, h) ((4 + (b) * 2 + (h)) * HTB)
#define PG8_STAGE(bufoff, gbase, voff) do { _Pragma("unroll") for (int _i = 0; _i < 2; ++_i) \
        __builtin_amdgcn_global_load_lds((const unsigned*)((const char*)(gbase) + (voff)[_i]), (PG8_LAS unsigned*)(lds + (bufoff) + ldsw + _i * 8192), 16, 0, 0); } while (0)
#define PG8_LDA(dst, b, h) do { _Pragma("unroll") for (int m = 0; m < 4; ++m) _Pragma("unroll") for (int k = 0; k < 2; ++k) dst[m][k] = *(const PG8_LAS bf16x8*)(lds + PG8_SA(b, h) + aoff + m * 2048 + k * 1024); } while (0)
#define PG8_LDB(dst, b, h) do { _Pragma("unroll") for (int n = 0; n < 2; ++n) _Pragma("unroll") for (int k = 0; k < 2; ++k) dst[n][k] = *(const PG8_LAS bf16x8*)(lds + PG8_SB(b, h) + boff + n * 2048 + k * 1024); } while (0)
#define PG8_MMA(ai, bj, At, Bt) do { __builtin_amdgcn_s_setprio(1); mma_blk<F8>(acc[ai][bj], At, Bt, g.scw, g.sca); __builtin_amdgcn_s_setprio(0); } while (0)
#define PG8_WAIT_V(n) asm volatile("s_waitcnt vmcnt(" #n ")" ::: "memory")
#define PG8_WAIT_L(n) asm volatile("s_waitcnt lgkmcnt(" #n ")" ::: "memory")
#define PG8_BAR __builtin_amdgcn_s_barrier()
#define PG8_SCHED __builtin_amdgcn_sched_barrier(0)
    Unit cur, nxt; int ui = 0;
    if (!S.next(0, cur)) return;
    f32x4 acc[2][2][4][2];
#pragma unroll
    for (int a = 0; a < 2; ++a)
#pragma unroll
        for (int b = 0; b < 2; ++b)
#pragma unroll
            for (int m = 0; m < 4; ++m)
#pragma unroll
                for (int n = 0; n < 2; ++n) acc[a][b][m][n] = (f32x4){0.f, 0.f, 0.f, 0.f};
    bf16x8 At[4][2], B0[2][2], B1[2][2];
    const char* cA = (const char*)g.A + (size_t)cur.pm * tstep; const char* cB = (const char*)g.Bt + (size_t)cur.pn * tstep;
    S.a_ready(cur);
    if constexpr (SP2) {
        PG8_STAGE(PG8_SB(0, 0), cB, voffB); PG8_STAGE(PG8_SB(0, 1), cB + hstep, voffB); PG8_STAGE(PG8_SA(0, 0), cA, voffA); PG8_STAGE(PG8_SA(0, 1), cA + hstep, voffA);
        if (wr == 1) PG8_BAR;
        PG8_WAIT_V(2); PG8_BAR;
        PG8_STAGE(PG8_SB(1, 0), cB + kstep, voffB); PG8_STAGE(PG8_SA(1, 0), cA + kstep, voffA); PG8_STAGE(PG8_SB(1, 1), cB + hstep + kstep, voffB);
        PG8_WAIT_V(6); PG8_BAR;
    } else {
        PG8_STAGE(PG8_SB(0, 0), cB, voffB); PG8_STAGE(PG8_SA(0, 0), cA, voffA); PG8_STAGE(PG8_SB(0, 1), cB + hstep, voffB); PG8_STAGE(PG8_SA(0, 1), cA + hstep, voffA);
        if (wr == 1) PG8_BAR;
        PG8_WAIT_V(4); PG8_BAR;
        PG8_STAGE(PG8_SB(1, 0), cB + kstep, voffB); PG8_STAGE(PG8_SA(1, 0), cA + kstep, voffA); PG8_STAGE(PG8_SB(1, 1), cB + hstep + kstep, voffB);
        PG8_WAIT_V(6); PG8_BAR;
    }
    for (;;) {
        const bool has_next = S.next(ui + 1, nxt);
        const char* nA = has_next ? (const char*)g.A + (size_t)nxt.pm * tstep : cA; const char* nB = has_next ? (const char*)g.Bt + (size_t)nxt.pn * tstep : cB;
        for (int t = 0; t < nt; t += 2) {
            const bool last = (t == nt - 2);
            const char* a1 = cA + (size_t)(t + 1) * kstep;
            const char* a2 = last ? nA : cA + (size_t)(t + 2) * kstep; const char* b2 = last ? nB : cB + (size_t)(t + 2) * kstep;
            const char* a3 = a2 + kstep; const char* b3 = b2 + kstep;
            if (last && has_next) S.a_ready(nxt);
            if constexpr (SP2) {
            PG8_LDB(B0, 0, 0); PG8_LDB(B1, 0, 1); PG8_SCHED; PG8_LDA(At, 0, 0); PG8_STAGE(PG8_SA(1, 1), a1 + hstep, voffA);
            PG8_WAIT_V(8); PG8_WAIT_L(0); PG8_BAR; PG8_MMA(0, 0, At, B0); PG8_MMA(0, 1, At, B1); PG8_BAR; PG8_SCHED;
            PG8_LDA(At, 0, 1); PG8_STAGE(PG8_SB(0, 0), b2, voffB); PG8_STAGE(PG8_SB(0, 1), b2 + hstep, voffB); PG8_STAGE(PG8_SA(0, 0), a2, voffA);
            PG8_WAIT_V(8); PG8_WAIT_L(0); PG8_BAR; PG8_MMA(1, 0, At, B0); PG8_MMA(1, 1, At, B1); PG8_BAR; PG8_SCHED;
            PG8_LDB(B0, 1, 0); PG8_LDB(B1, 1, 1); PG8_SCHED; PG8_LDA(At, 1, 0); PG8_STAGE(PG8_SA(0, 1), a2 + hstep, voffA);
            PG8_WAIT_V(8); PG8_WAIT_L(0); PG8_BAR; PG8_MMA(0, 0, At, B0); PG8_MMA(0, 1, At, B1); PG8_BAR; PG8_SCHED;
            PG8_LDA(At, 1, 1); PG8_STAGE(PG8_SB(1, 0), b3, voffB); PG8_STAGE(PG8_SB(1, 1), b3 + hstep, voffB); PG8_STAGE(PG8_SA(1, 0), a3, voffA);
            PG8_WAIT_V(8); PG8_WAIT_L(0); PG8_BAR; PG8_MMA(1, 0, At, B0); PG8_MMA(1, 1, At, B1); PG8_BAR; PG8_SCHED;
            } else {
            PG8_LDB(B0, 0, 0); PG8_SCHED; PG8_LDA(At, 0, 0); PG8_STAGE(PG8_SA(1, 1), a1 + hstep, voffA);
            PG8_WAIT_L(8); PG8_BAR; PG8_WAIT_L(0); PG8_MMA(0, 0, At, B0); PG8_BAR; PG8_SCHED;
            PG8_LDB(B1, 0, 1); PG8_STAGE(PG8_SB(0, 0), b2, voffB);
            PG8_BAR; PG8_WAIT_L(0); PG8_MMA(0, 1, At, B1); PG8_BAR;
            PG8_LDA(At, 0, 1); PG8_STAGE(PG8_SA(0, 0), a2, voffA);
            PG8_BAR; PG8_WAIT_L(0); PG8_MMA(1, 0, At, B0); PG8_BAR; PG8_SCHED;
            PG8_STAGE(PG8_SB(0, 1), b2 + hstep, voffB);
            PG8_WAIT_V(6); PG8_BAR; PG8_MMA(1, 1, At, B1); PG8_BAR;
            PG8_LDB(B0, 1, 0); PG8_SCHED; PG8_LDA(At, 1, 0); PG8_STAGE(PG8_SA(0, 1), a2 + hstep, voffA);
            PG8_WAIT_L(8); PG8_BAR; PG8_WAIT_L(0); PG8_MMA(0, 0, At, B0); PG8_BAR; PG8_SCHED;
            PG8_LDB(B1, 1, 1); PG8_STAGE(PG8_SB(1, 0), b3, voffB);
            PG8_BAR; PG8_WAIT_L(0); PG8_MMA(0, 1, At, B1); PG8_BAR;
            PG8_LDA(At, 1, 1); PG8_STAGE(PG8_SA(1, 0), a3, voffA);
            PG8_BAR; PG8_WAIT_L(0); PG8_MMA(1, 0, At, B0); PG8_BAR; PG8_SCHED;
            PG8_STAGE(PG8_SB(1, 1), b3 + hstep, voffB);
            PG8_WAIT_V(6); PG8_BAR; PG8_MMA(1, 1, At, B1); PG8_BAR;
            }
        }
        if constexpr (ALIGN_EPI) { if (wr == 0) PG8_BAR; }
        if constexpr (F8) asm volatile("s_nop 15\n\ts_nop 15" ::: "memory");
        if constexpr (!Epi::AFTER_DRAIN) { E(acc, cur, wr, wc, fr, fq); S.done(cur); }
        if (!has_next) break;
#pragma unroll
        for (int a = 0; a < 2; ++a)
#pragma unroll
            for (int b = 0; b < 2; ++b)
#pragma unroll
                for (int m = 0; m < 4; ++m)
#pragma unroll
                    for (int n = 0; n < 2; ++n) acc[a][b][m][n] = (f32x4){0.f, 0.f, 0.f, 0.f};
        cur = nxt; cA = nA; cB = nB; ++ui;
        if constexpr (ALIGN_EPI) { if (wr == 1) PG8_BAR; }
    }
    PG8_WAIT_V(0);
    if constexpr (!ALIGN_EPI) { if (wr == 0) PG8_BAR; }
    PG8_BAR;
    if constexpr (Epi::AFTER_DRAIN) { E.fused(acc, cur, wr, wc, fr, fq, lds, wid, lane); S.done(cur); }
#undef PG8_SA
#undef PG8_SB
#undef PG8_STAGE
#undef PG8_LDA
#undef PG8_LDB
#undef PG8_MMA
#undef PG8_WAIT_V
#undef PG8_WAIT_L
#undef PG8_BAR
#undef PG8_SCHED
}
}

#ifndef PG8_SP2
#define PG8_SP2 true
#endif
#ifndef PG8_ALIGN
#define PG8_ALIGN true
#endif
constexpr int NWAVES = 8;
#ifndef MK_ONE_LAUNCH
#define MK_ONE_LAUNCH 1
#endif
constexpr int NPH = 19;

constexpr int NB = 4, SEQ = 4096, D = 2048, NTOK = NB * SEQ;
constexpr int GH = 4, GDK = 256, GDV = 512, NIN = 6144, LDW_IN = 6160;
constexpr int FD = 5504, NE = 8, FE = 7168;
constexpr int MH = 16, MKV = 4, HD = 128, MBLK = 256, NBLK = 16, NKVQ = 3072;
constexpr int XG_ROWS = 34816;
constexpr float ALPHA = 1.41421356237309515f;
constexpr float LN_EPS = 1e-5f, RMS_EPS = 1e-6f;
constexpr float WSC_GU = 64.f, WSC_DN = 256.f, XSC = 4.f, ASC = 4.f, WSC_OB = 128.f, OSC = 32.f, YSC = 8.f;

constexpr size_t MiB = 1u << 20;
constexpr size_t WS_CTL = 0, CTL_ZERO_BYTES = 1 * MiB;
constexpr size_t WS_W_IN = 2 * MiB;
constexpr size_t WS_W_OA = WS_W_IN + (size_t)NIN * D * 2;
constexpr size_t WS_W_GUD = WS_W_OA + (size_t)D * D * 2;
constexpr size_t WS_W_DD = WS_W_GUD + (size_t)2 * FD * D * 2;
constexpr size_t WS_W_KVQ = WS_W_DD + (size_t)D * FD * 2;
constexpr size_t WS_W_OB = WS_W_KVQ + (size_t)NKVQ * D * 2;
constexpr size_t WS_W_GUM = WS_W_OB + (size_t)D * D * 2;
constexpr size_t WS_W_DM = WS_W_GUM + (size_t)NE * 2 * FE * D * 2;
constexpr size_t WS_XB = WS_W_DM + (size_t)NE * D * FE * 2;
constexpr size_t WS_PROJ = WS_XB + (size_t)NTOK * D * 2;
constexpr size_t WS_LA = WS_PROJ + (size_t)NTOK * NIN * 2;
constexpr size_t WS_OGLA = WS_LA + (size_t)NTOK * 1024 * 4;
constexpr size_t WS_A3 = WS_OGLA + (size_t)NTOK * D * 4;
constexpr size_t WS_T = WS_A3 + (size_t)NTOK * D * 2;
constexpr size_t WS_H1 = WS_T + (size_t)NTOK * D * 4;
constexpr size_t WS_H2 = WS_H1 + (size_t)NTOK * D * 2;
constexpr size_t WS_H3 = WS_H2 + (size_t)NTOK * D * 2;
constexpr size_t WS_ACT = WS_H3 + (size_t)NTOK * D * 2;
constexpr size_t WS_KVQ = WS_ACT + (size_t)NTOK * FD * 2;
constexpr size_t WS_KM = WS_KVQ + (size_t)NTOK * NKVQ * 2;
constexpr size_t WS_XG = WS_KM + 1 * MiB;
constexpr size_t WS_ACTM = WS_XG + (size_t)NE * NTOK * D;
constexpr size_t WS_Y = WS_ACTM + (size_t)XG_ROWS * FE * 2;
constexpr size_t WS_TOKINFO = WS_Y + (size_t)XG_ROWS * D * 2;
constexpr size_t WS_LIST = WS_TOKINFO + (size_t)NTOK * 32;
constexpr size_t WS_QD = WS_LIST + (size_t)NE * NTOK * 4;
constexpr size_t WS_KET = WS_QD + (size_t)NTOK * 1024 * 2;
constexpr size_t WS_VT = WS_KET + (size_t)NTOK * 1024 * 2;
constexpr size_t WS_ATTG = WS_VT + (size_t)NTOK * 2048 * 2;
constexpr size_t WS_DEC = WS_ATTG + (size_t)1024 * 64 * 64 * 2;
constexpr size_t WS_SLOTS = WS_DEC + (size_t)1024 * 256 * 4;
constexpr size_t WS_K8 = WS_SLOTS + (size_t)3 * NTOK * 8 * 8;
constexpr size_t WS_V8T = WS_K8 + (size_t)NTOK * 512;
constexpr size_t WS_END = WS_V8T + (size_t)NTOK * 512;
constexpr int CW_CNT = 1024;
constexpr int CW_BAR = 4096;
constexpr int CW_XRANK = 3072;
constexpr int CW_SCANQ = 2048;
constexpr int CW_TMO = 8, CW_PANEL = 16384;

constexpr int RING_OFF = 0, RING_BYTES = 135168;
constexpr int LDSCTL_OFF = RING_BYTES, MISC_OFF = LDSCTL_OFF + 320, TAB_OFF = LDSCTL_OFF + 1024, LNTAB_OFF = LDSCTL_OFF + 2048;
constexpr int LDS_BYTES = 147456;
static_assert(TAB_OFF + 768 <= LNTAB_OFF && LNTAB_OFF + 10240 <= LDS_BYTES, "LDS map");

#define GAS __attribute__((address_space(1)))
#define LAS __attribute__((address_space(3)))
typedef unsigned short bf16;
typedef unsigned v4u __attribute__((ext_vector_type(4)));
typedef unsigned v2u __attribute__((ext_vector_type(2)));
typedef float f32x4 __attribute__((ext_vector_type(4)));
typedef float f32x16 __attribute__((ext_vector_type(16)));
typedef short bf16x8 __attribute__((ext_vector_type(8)));
typedef short s16x4 __attribute__((ext_vector_type(4)));
typedef GAS unsigned gu32;
#define LDS_WAIT() asm volatile("s_waitcnt lgkmcnt(0)" ::: "memory")
#define VM_WAIT() asm volatile("s_waitcnt vmcnt(0)" ::: "memory")
__device__ __forceinline__ unsigned pk2(float lo, float hi) { unsigned r; asm volatile("v_cvt_pk_bf16_f32 %0, %1, %2" : "=v"(r) : "v"(lo), "v"(hi)); return r; }
__device__ __forceinline__ float bflo(unsigned u) { return __uint_as_float(u << 16); }
__device__ __forceinline__ float bfhi(unsigned u) { return __uint_as_float(u & 0xffff0000u); }
__device__ __forceinline__ float bf1(bf16 b) { return __uint_as_float((unsigned)b << 16); }
__device__ __forceinline__ float wave_sum(float v) {
#pragma unroll
    for (int o = 1; o < 64; o <<= 1) v += __shfl_xor(v, o);
    return v;
}
__device__ __forceinline__ float silu1(float x) { return x / (1.0f + __expf(-x)); }

#define MFMA32(a, b, c) __builtin_amdgcn_mfma_f32_32x32x16_bf16((a), (b), (c), 0, 0, 0)
#define RAW_BAR() do { asm volatile("s_waitcnt lgkmcnt(0)" ::: "memory"); __builtin_amdgcn_s_barrier(); asm volatile("" ::: "memory"); } while (0)
#define XB_TMO      128
#define XB_XCNT(j)  (256  + 64 * (j))
#define XB_XSUB(j)  (1280 + 64 * (j))
#define XB_XGEN(j)  (2304 + 64 * (j))
#define XB_TOP      3328
#define XB_TOPGEN   3392
#define XCD_BAR_WORDS 3456
#define XB_SPIN_CAP (1u << 18)

__device__ __forceinline__ unsigned xb_ld(unsigned* p)              { return __hip_atomic_load(p, __ATOMIC_RELAXED, __HIP_MEMORY_SCOPE_AGENT); }
__device__ __forceinline__ unsigned xb_add(unsigned* p, unsigned v) { return __hip_atomic_fetch_add(p, v, __ATOMIC_RELAXED, __HIP_MEMORY_SCOPE_AGENT); }
__device__ __forceinline__ unsigned xb_xcc_id() { return (unsigned)__builtin_amdgcn_s_getreg((3 << 11) | 20) & 0xFu; }
#define XB_SPIN(cond, bar) do { unsigned _sp = 0; while (cond) { __builtin_amdgcn_s_sleep(1); \
    if ((++_sp & 255u) == 0u) { if (xb_ld(&(bar)[XB_TMO])) break; if (_sp > XB_SPIN_CAP) { atomicAdd(&(bar)[XB_TMO], 1u); break; } } } } while (0)

struct XcdBarrier {
    unsigned* bar; unsigned x;
    volatile LAS unsigned* st;
};

__device__ __forceinline__ XcdBarrier xcd_barrier_post(unsigned* bar, volatile LAS unsigned* st) {
    XcdBarrier b; b.bar = bar; b.x = xb_xcc_id(); b.st = st;
    if (threadIdx.x == 0) (void)xb_add(&bar[XB_XCNT(b.x)], 1u);
    return b;
}
__device__ __forceinline__ void xcd_barrier_complete(unsigned* bar, unsigned x, unsigned& nloc, unsigned& nx) {
    const unsigned G = gridDim.x * gridDim.y * gridDim.z;
    unsigned sum, cnt, mine, sp = 0u;
    for (;;) {
        sum = 0u; cnt = 0u; mine = 0u;
#pragma unroll
        for (unsigned j = 0; j < 16; ++j) { const unsigned c = xb_ld(&bar[XB_XCNT(j)]); sum += c; cnt += (c > 0u) ? 1u : 0u; mine = (j == x) ? c : mine; }
        if (sum == G) break;
        __builtin_amdgcn_s_sleep(1);
        if ((++sp & 255u) == 0u) { if (xb_ld(&bar[XB_TMO])) break; if (sp > XB_SPIN_CAP) { atomicAdd(&bar[XB_TMO], 1u); break; } }
    }
    nloc = mine > 0u ? mine : 1u; nx = cnt > 0u ? cnt : 1u;
}

__device__ __forceinline__ void xcd_barrier(const XcdBarrier& b) {
    asm volatile("s_waitcnt vmcnt(0)" ::: "memory");
    __syncthreads();
    if (threadIdx.x == 0) {
        unsigned* bar = b.bar;
        __builtin_amdgcn_s_waitcnt(0);
        unsigned nloc = b.st[0], nx = b.st[1];
        if (nloc == 0u) { xcd_barrier_complete(bar, b.x, nloc, nx); b.st[0] = nloc; b.st[1] = nx; }
        const unsigned old = xb_add(&bar[XB_XSUB(b.x)], 1u);
        const unsigned gen = old / nloc;
        if (old + 1u == (gen + 1u) * nloc) {
            __builtin_amdgcn_fence(__ATOMIC_RELEASE, "agent");
            asm volatile("s_waitcnt vmcnt(0)" ::: "memory");
            const unsigned og = xb_add(&bar[XB_TOP], 1u);
            const unsigned tg = og / nx;
            if (og + 1u == (tg + 1u) * nx) xb_add(&bar[XB_TOPGEN], 1u);
            else XB_SPIN(xb_ld(&bar[XB_TOPGEN]) == tg, bar);
            __builtin_amdgcn_fence(__ATOMIC_ACQUIRE, "agent");
            xb_add(&bar[XB_XGEN(b.x)], 1u);
            asm volatile("s_waitcnt vmcnt(0)" ::: "memory");
        } else {
            XB_SPIN(xb_ld(&bar[XB_XGEN(b.x)]) == gen, bar);
            __builtin_amdgcn_fence(__ATOMIC_ACQUIRE, "agent");
            asm volatile("s_waitcnt vmcnt(0)" ::: "memory");
        }
    }
    __syncthreads();
}


struct Frame {
    LAS unsigned char* lds;
    volatile LAS unsigned* MISC;
    gu32* ctl;
    int tid, lane, wave;
    int G;
    unsigned char* ws;
    const float* in[18];
    float* out;
};
#define WSP(T, off) ((T*)(F.ws + (off)))

__device__ __forceinline__ void tr_item(const float* W, size_t ldw, int k0, int n0, bf16* WT, size_t drow0, int Kd, float scale, LAS float* scr, int lane) {
    { float t_[32]; const float* wp = W + (size_t)(k0 + (lane >> 5)) * ldw + n0 + (lane & 31);
#pragma unroll
      for (int i = 0; i < 32; ++i) t_[i] = wp[(size_t)(2 * i) * ldw];
#pragma unroll
      for (int i = 0; i < 32; ++i) scr[(2 * i + (lane >> 5)) * 33 + (lane & 31)] = t_[i]; }
    LDS_WAIT(); asm volatile("" ::: "memory");
    const int c = lane & 7;
#pragma unroll
    for (int j = 0; j < 4; ++j) { const int n = (lane >> 3) + 8 * j; const LAS float* s = scr + (8 * c) * 33 + n;
        v4u o; o.x = pk2(s[0 * 33] * scale, s[1 * 33] * scale); o.y = pk2(s[2 * 33] * scale, s[3 * 33] * scale); o.z = pk2(s[4 * 33] * scale, s[5 * 33] * scale); o.w = pk2(s[6 * 33] * scale, s[7 * 33] * scale);
        *(GAS v4u*)(WT + (drow0 + n) * (size_t)Kd + k0 + 8 * c) = o; }
    LDS_WAIT(); asm volatile("" ::: "memory");
}
__device__ __forceinline__ unsigned pk4f8(float a, float b, float c, float d) { int r = __builtin_amdgcn_cvt_pk_fp8_f32(a, b, 0, false); r = __builtin_amdgcn_cvt_pk_fp8_f32(c, d, r, true); return (unsigned)r; }
__device__ __forceinline__ void tr_item_f8(const float* W, size_t ldw, int k0, int n0, unsigned char* WT, size_t drow0, int Kd, float scale, LAS float* scr, int lane) {
    const float* wp = W + (size_t)(k0 + (lane >> 5)) * ldw + n0 + (lane & 31);
#pragma unroll
    for (int hb = 0; hb < 2; ++hb) { float t_[32];
#pragma unroll
        for (int i = 0; i < 32; ++i) t_[i] = wp[(size_t)(64 * hb + 2 * i) * ldw];
#pragma unroll
        for (int i = 0; i < 32; ++i) scr[(64 * hb + 2 * i + (lane >> 5)) * 33 + (lane & 31)] = t_[i]; }
    LDS_WAIT(); asm volatile("" ::: "memory");
    const int c = lane & 7;
#pragma unroll
    for (int j = 0; j < 4; ++j) { const int n = (lane >> 3) + 8 * j; const LAS float* s = scr + (16 * c) * 33 + n;
        v4u o; o.x = pk4f8(s[0 * 33] * scale, s[1 * 33] * scale, s[2 * 33] * scale, s[3 * 33] * scale); o.y = pk4f8(s[4 * 33] * scale, s[5 * 33] * scale, s[6 * 33] * scale, s[7 * 33] * scale);
        o.z = pk4f8(s[8 * 33] * scale, s[9 * 33] * scale, s[10 * 33] * scale, s[11 * 33] * scale); o.w = pk4f8(s[12 * 33] * scale, s[13 * 33] * scale, s[14 * 33] * scale, s[15 * 33] * scale);
        *(GAS v4u*)(WT + (drow0 + n) * (size_t)Kd + k0 + 16 * c) = o; }
    LDS_WAIT(); asm volatile("" ::: "memory");
}
typedef float v16f __attribute__((ext_vector_type(16)));
typedef int v6i_t __attribute__((ext_vector_type(6)));
__device__ __forceinline__ float amax3(float a, float b, float c) { float r; asm("v_max3_f32 %0, |%1|, |%2|, |%3|" : "=v"(r) : "v"(a), "v"(b), "v"(c)); return r; }
__device__ __forceinline__ void mx6_record(const v16f& x0, const v16f& x1, v4u& p0, v4u& p1) {
    float m0 = amax3(x0[0], x0[1], x0[2]), m1 = amax3(x1[0], x1[1], x1[2]);
#pragma unroll
    for (int i = 3; i < 15; i += 2) { m0 = amax3(m0, x0[i], x0[i + 1]); m1 = amax3(m1, x1[i], x1[i + 1]); }
    const float mx = amax3(m0, m1, x0[15]), mx2 = amax3(mx, x1[15], x1[15]);
    unsigned sb = (__float_as_uint(mx2 * 0.13333334f) + 0x007FFFFFu) & 0x7F800000u;
    sb = sb < 0x00800000u ? 0x00800000u : sb;
    const v6i_t r = __builtin_amdgcn_cvt_scalef32_2xpk16_fp6_f32(x0, x1, __uint_as_float(sb));
    p0 = (v4u){(unsigned)r[0], (unsigned)r[1], (unsigned)r[2], (unsigned)r[3]}; p1 = (v4u){(unsigned)r[4], (unsigned)r[5], sb >> 23, 0u};
}
__device__ __forceinline__ void tr_item_f6(const float* W, size_t ldw, int k0, int n0, unsigned char* WT, size_t drow0, int Kd, LAS float* scr, int lane) {
    const float* wp = W + (size_t)(k0 + (lane >> 5)) * ldw + n0 + (lane & 31);
#pragma unroll
    for (int hb = 0; hb < 2; ++hb) { float t_[32];
#pragma unroll
        for (int i = 0; i < 32; ++i) t_[i] = wp[(size_t)(64 * hb + 2 * i) * ldw];
#pragma unroll
        for (int i = 0; i < 32; ++i) scr[(64 * hb + 2 * i + (lane >> 5)) * 33 + (lane & 31)] = t_[i]; }
    LDS_WAIT(); asm volatile("" ::: "memory");
    const int q = lane & 3;
#pragma unroll
    for (int j = 0; j < 2; ++j) { const int n = (lane >> 2) + 16 * j; const LAS float* s = scr + (32 * q) * 33 + n;
        v16f x0, x1;
#pragma unroll
        for (int i = 0; i < 16; ++i) { x0[i] = s[i * 33]; x1[i] = s[(16 + i) * 33]; }
        v4u p0, p1; mx6_record(x0, x1, p0, p1);
        unsigned char* o = WT + (drow0 + n) * (size_t)Kd + k0 + 16 * q;
        *(GAS v4u*)o = p0; *(GAS v4u*)(o + 64) = p1; }
    LDS_WAIT(); asm volatile("" ::: "memory");
}
template <int PART, bool RO = false> __device__ __forceinline__ void p0_expert(Frame& F) {
    LAS float* scr = (LAS float*)(F.lds + RING_OFF + F.wave * 16896);
    const int gw = blockIdx.x * NWAVES + F.wave, NGW = F.G * NWAVES, lane = F.lane;
    constexpr int I_GUM1 = 16 * 448, I_DM1 = 56 * 64, N = PART == 1 ? NE * I_GUM1 : NE * I_DM1;
    constexpr size_t ldw = PART == 1 ? (size_t)2 * FE : (size_t)D;
#define P0E_SRC(r_) (PART == 1 ? F.in[14] + (size_t)((r_) / I_GUM1) * D * 2 * FE + (size_t)(128 * (((r_) % I_GUM1) / 448) + (lane >> 5)) * ldw + (((((r_) % I_GUM1) % 448) & 7) >> 2) * FE + ((((r_) % I_GUM1) % 448) >> 3) * 128 + (((((r_) % I_GUM1) % 448) & 7) & 3) * 32 + (lane & 31) \
                              : F.in[15] + (size_t)((r_) / I_DM1) * FE * D + (size_t)(128 * (((r_) % I_DM1) / 64) + (lane >> 5)) * ldw + 32 * (((r_) % I_DM1) % 64) + (lane & 31))
    float t_[64];
    int r = gw;
    if (r < N) { const float* wp = P0E_SRC(r);
#pragma unroll
        for (int i = 0; i < 64; ++i) t_[i] = wp[(size_t)(2 * i) * ldw]; }
    while (r < N) {
#pragma unroll
        for (int i = 0; i < 64; ++i) scr[(2 * i + (lane >> 5)) * 33 + (lane & 31)] = t_[i];
        const int rn = r + NGW;
        if (rn < N) { const float* wp = P0E_SRC(rn);
#pragma unroll
            for (int i = 0; i < 64; ++i) t_[i] = wp[(size_t)(2 * i) * ldw]; }
        LDS_WAIT(); asm volatile("" ::: "memory");
        if (RO) { r = rn; continue; }
        if (PART == 1) { const int e = r / I_GUM1, rr = r % I_GUM1, kb = rr / 448, nb = rr % 448; unsigned char* WT = WSP(unsigned char, WS_W_GUM); const size_t drow0 = (size_t)e * 2 * FE + 32 * nb; const int k0 = 128 * kb;
            const int q = lane & 3;
#pragma unroll
            for (int j = 0; j < 2; ++j) { const int n = (lane >> 2) + 16 * j; const LAS float* s = scr + (32 * q) * 33 + n;
                v16f x0, x1;
#pragma unroll
                for (int i = 0; i < 16; ++i) { x0[i] = s[i * 33]; x1[i] = s[(16 + i) * 33]; }
                v4u p0, p1; mx6_record(x0, x1, p0, p1);
                unsigned char* o = WT + (drow0 + n) * (size_t)D + k0 + 16 * q;
                *(GAS v4u*)o = p0; *(GAS v4u*)(o + 64) = p1; } }
        else { const int e = r / I_DM1, rr = r % I_DM1, kb = rr / 64, nb = rr % 64; unsigned char* WT = WSP(unsigned char, WS_W_DM); const size_t drow0 = (size_t)e * D + 32 * nb; const int k0 = 128 * kb; const float scale = WSC_DN;
            const int c = lane & 7;
#pragma unroll
            for (int j = 0; j < 4; ++j) { const int n = (lane >> 3) + 8 * j; const LAS float* s = scr + (16 * c) * 33 + n;
                v4u o; o.x = pk4f8(s[0 * 33] * scale, s[1 * 33] * scale, s[2 * 33] * scale, s[3 * 33] * scale); o.y = pk4f8(s[4 * 33] * scale, s[5 * 33] * scale, s[6 * 33] * scale, s[7 * 33] * scale);
                o.z = pk4f8(s[8 * 33] * scale, s[9 * 33] * scale, s[10 * 33] * scale, s[11 * 33] * scale); o.w = pk4f8(s[12 * 33] * scale, s[13 * 33] * scale, s[14 * 33] * scale, s[15 * 33] * scale);
                *(GAS v4u*)(WT + (drow0 + n) * (size_t)FE + k0 + 16 * c) = o; } }
        LDS_WAIT(); asm volatile("" ::: "memory");
        r = rn;
    }
#undef P0E_SRC
}
template <int PART> __device__ __forceinline__ void p0_prologue(Frame& F) {
    LAS float* scr = (LAS float*)(F.lds + RING_OFF + F.wave * 16896);
    const int gw = blockIdx.x * NWAVES + F.wave, NGW = F.G * NWAVES, lane = F.lane;
    constexpr int I_IN = 32 * 192, I_OA = 32 * 64, I_GUD = 32 * 344, I_DD = 86 * 64, I_KV = 32 * 32, I_Q = 32 * 64, I_OB = 16 * 64, I_GUM1 = 16 * 448, I_DM1 = 56 * 64;
    constexpr int NITEMS = I_IN + I_OA + I_GUD + I_DD + I_KV + I_Q + I_OB + NE * I_GUM1 + NE * I_DM1;
    constexpr int NDENSE = I_IN + I_OA + I_GUD + I_DD + I_KV + I_Q + I_OB;
    for (int it = (PART == 0 ? 0 : NDENSE) + gw; it < (PART == 0 ? NDENSE : NITEMS); it += NGW) {
        int r = it;
        if (r < I_IN) { const int kb = r / 192, nb = r % 192; tr_item(F.in[1], LDW_IN, 64 * kb, 32 * nb, WSP(bf16, WS_W_IN), 32 * nb, D, nb < 32 ? 0.0625f : 1.0f, scr, lane); continue; } r -= I_IN;
        if (r < I_OA) { const int kb = r / 64, nb = r % 64; tr_item(F.in[5], D, 64 * kb, 32 * nb, WSP(bf16, WS_W_OA), 32 * nb, D, 1.0f, scr, lane); continue; } r -= I_OA;
        if (r < I_GUD) { const int kb = r / 344, nb = r % 344, pn = nb >> 3, q = nb & 7, half = q >> 2, cg = q & 3;
            tr_item(F.in[11], 2 * FD, 64 * kb, half * FD + pn * 128 + cg * 32, WSP(bf16, WS_W_GUD), 32 * nb, D, 1.0f, scr, lane); continue; } r -= I_GUD;
        if (r < I_DD) { const int kb = r / 64, nb = r % 64; tr_item(F.in[12], D, 64 * kb, 32 * nb, WSP(bf16, WS_W_DD), 32 * nb, FD, 1.0f, scr, lane); continue; } r -= I_DD;
        if (r < I_KV) { const int kb = r / 32, nb = r % 32; tr_item(F.in[6], 1024, 64 * kb, 32 * nb, WSP(bf16, WS_W_KVQ), 32 * nb, D, 1.0f, scr, lane); continue; } r -= I_KV;
        if (r < I_Q) { const int kb = r / 64, nb = r % 64; tr_item(F.in[7], D, 64 * kb, 32 * nb, WSP(bf16, WS_W_KVQ), 1024 + 32 * nb, D, 0.08838834764831845f, scr, lane); continue; } r -= I_Q;
        if (r < I_OB) { const int kb = r / 64, nb = r % 64; tr_item_f8(F.in[8], D, 128 * kb, 32 * nb, WSP(unsigned char, WS_W_OB), 32 * nb, D, WSC_OB, scr, lane); continue; } r -= I_OB;
        if (r < NE * I_GUM1) { const int e = r / I_GUM1, rr = r % I_GUM1, kb = rr / 448, nb = rr % 448, pn = nb >> 3, q = nb & 7, half = q >> 2, cg = q & 3;
            tr_item_f6(F.in[14] + (size_t)e * D * 2 * FE, 2 * FE, 128 * kb, half * FE + pn * 128 + cg * 32, WSP(unsigned char, WS_W_GUM), (size_t)e * 2 * FE + 32 * nb, D, scr, lane); continue; } r -= NE * I_GUM1;
        { const int e = r / I_DM1, rr = r % I_DM1, kb = rr / 64, nb = rr % 64;
            tr_item_f8(F.in[15] + (size_t)e * FE * D, D, 128 * kb, 32 * nb, WSP(unsigned char, WS_W_DM), (size_t)e * D + 32 * nb, FE, WSC_DN, scr, lane); }
    }
    const float* x = F.in[0]; bf16* xb = WSP(bf16, WS_XB);
    if (PART == 0) for (size_t i = (size_t)blockIdx.x * 512 + F.tid; i < (size_t)NTOK * D / 8; i += (size_t)F.G * 512) {
        const f32x4 a = *(const GAS f32x4*)(x + i * 8), b = *(const GAS f32x4*)(x + i * 8 + 4);
        v4u o; o.x = pk2(a[0], a[1]); o.y = pk2(a[2], a[3]); o.z = pk2(b[0], b[1]); o.w = pk2(b[2], b[3]);
        *(GAS v4u*)(xb + i * 8) = o; }
}

#define MFMA16G(a, b, c) __builtin_amdgcn_mfma_f32_16x16x32_bf16((a), (b), (c), 0, 0, 0)
constexpr int WZP = 2056;
__device__ __forceinline__ void p1_gate(Frame& F) {
    LAS bf16* wzt = (LAS bf16*)(F.lds + RING_OFF);
    LAS bf16* wgt = wzt + 16 * WZP;
    LAS float* zp = (LAS float*)(wgt + 1024 * 16);
    LAS bf16* zt = (LAS bf16*)(zp + 4 * 64 * 4);
    const float* w_in = F.in[1]; const float* wg = F.in[2]; const float* bg = F.in[3];
    const bf16* xb = WSP(bf16, WS_XB); float* la = WSP(float, WS_LA);
    const int tid = F.tid, lane = F.lane, w = F.wave, fr = lane & 15, fq = lane >> 4;
    { const int n = tid & 15, kg = tid >> 4;
#pragma unroll 2
      for (int i = 0; i < 8; ++i) { const int k0 = kg * 64 + 8 * i; const float* p = w_in + (size_t)k0 * LDW_IN + NIN + n;
          v4u o; o.x = pk2(p[0], p[LDW_IN]); o.y = pk2(p[2 * LDW_IN], p[3 * LDW_IN]); o.z = pk2(p[4 * LDW_IN], p[5 * LDW_IN]); o.w = pk2(p[6 * LDW_IN], p[7 * LDW_IN]);
          *(LAS v4u*)(wzt + n * WZP + k0) = o; } }
#pragma unroll
    for (int r = 0; r < 2; ++r) { const int n = tid + 512 * r; const float* p = wg + n;
        v4u o0, o1; o0.x = pk2(p[0], p[1024]); o0.y = pk2(p[2 * 1024], p[3 * 1024]); o0.z = pk2(p[4 * 1024], p[5 * 1024]); o0.w = pk2(p[6 * 1024], p[7 * 1024]);
        o1.x = pk2(p[8 * 1024], p[9 * 1024]); o1.y = pk2(p[10 * 1024], p[11 * 1024]); o1.z = pk2(p[12 * 1024], p[13 * 1024]); o1.w = pk2(p[14 * 1024], p[15 * 1024]);
        *(LAS v4u*)(wgt + n * 16) = o0; *(LAS v4u*)(wgt + n * 16 + 8) = o1; }
    __syncthreads();
    const bf16x8 zero8 = {0, 0, 0, 0, 0, 0, 0, 0};
    bf16x8 aw[8]; f32x4 bias[8];
#pragma unroll
    for (int q = 0; q < 8; ++q) { const int nt = 8 * w + q; aw[q] = (fq < 2) ? *(const LAS bf16x8*)(wgt + (16 * nt + fr) * 16 + 8 * fq) : zero8; bias[q] = *(const GAS f32x4*)(bg + 16 * nt + 4 * fq); }
    const int tile = w & 3, kh = w >> 2;
    for (int blk = blockIdx.x; blk < NTOK / 64; blk += F.G) {
        const size_t tok0 = (size_t)blk * 64 + tile * 16;
        f32x4 acc = {0.f, 0.f, 0.f, 0.f};
        const bf16* xr = xb + (tok0 + fr) * D + kh * 1024 + 8 * fq; const LAS bf16* wr = wzt + fr * WZP + kh * 1024 + 8 * fq;
#pragma unroll 8
        for (int ks = 0; ks < 32; ++ks) acc = MFMA16G(*(const GAS bf16x8*)(xr + 32 * ks), *(const LAS bf16x8*)(wr + 32 * ks), acc);
        if (kh == 1) *(LAS f32x4*)(zp + (tile * 64 + lane) * 4) = acc;
        __syncthreads();
        if (kh == 0) { acc = acc + *(const LAS f32x4*)(zp + (tile * 64 + lane) * 4);
#pragma unroll
            for (int i = 0; i < 4; ++i) zt[(tile * 16 + 4 * fq + i) * 16 + fr] = (bf16)(pk2(acc[i], 0.f) & 0xffffu); }
        __syncthreads();
#pragma unroll
        for (int t = 0; t < 4; ++t) { const bf16x8 bz = (fq < 2) ? *(const LAS bf16x8*)(zt + (t * 16 + fr) * 16 + 8 * fq) : zero8;
#pragma unroll
            for (int q = 0; q < 8; ++q) { f32x4 d = {0.f, 0.f, 0.f, 0.f}; d = MFMA16G(aw[q], bz, d);
                f32x4 o;
#pragma unroll
                for (int i = 0; i < 4; ++i) { const float a = d[i] + bias[q][i]; o[i] = (fminf(a, 0.f) - log1pf(__expf(-fabsf(a)))) * 0.0625f; }
                *(GAS f32x4*)(la + ((size_t)blk * 64 + t * 16 + fr) * 1024 + 16 * (8 * w + q) + 4 * fq) = o; } }
        __syncthreads();
    }
}

#define MFMA16(a, b, c) __builtin_amdgcn_mfma_f32_16x16x32_bf16((a), (b), (c), 0, 0, 0)
constexpr int GP = 264;
__device__ __forceinline__ void p2a_gla_pre(Frame& F) {
    LAS bf16* qd = (LAS bf16*)(F.lds + RING_OFF);
    LAS bf16* ki = qd + 64 * GP;
    LAS bf16* ke = ki + 64 * GP;
    LAS float* tot = (LAS float*)(ke + 64 * GP);
    const bf16* proj = WSP(bf16, WS_PROJ); const float* la = WSP(float, WS_LA);
    const int tid = F.tid, lane = F.lane, w = F.wave, fr = lane & 15, fq = lane >> 4;
    const int cseg = tid >> 6, t4 = (tid & 63) * 4;
    for (int it = blockIdx.x; it < NB * GH * 64; it += F.G) {
        const int b = it >> 8, h = (it >> 6) & 3, n = it & 63;
        const size_t row0 = (size_t)b * SEQ + n * 64;
        bf16* QD = WSP(bf16, WS_QD) + (size_t)it * 64 * 256; bf16* KET = WSP(bf16, WS_KET) + (size_t)it * 256 * 64;
        bf16* ATT = WSP(bf16, WS_ATTG) + (size_t)it * 64 * 64; float* DEC = WSP(float, WS_DEC) + (size_t)it * 256;
        f32x4 bc[8]; v2u rq[8], rk[8];
#pragma unroll
        for (int i = 0; i < 8; ++i) { const size_t r = row0 + 8 * cseg + i;
            bc[i] = *(const GAS f32x4*)(la + r * 1024 + h * 256 + t4);
            rq[i] = *(const GAS v2u*)(proj + r * NIN + h * 256 + t4); rk[i] = *(const GAS v2u*)(proj + r * NIN + 1024 + h * 256 + t4); }
#pragma unroll
        for (int i = 1; i < 8; ++i) bc[i] = bc[i] + bc[i - 1];
        *(LAS f32x4*)(tot + cseg * 256 + t4) = bc[7];
        __syncthreads();
        f32x4 pre = {0.f, 0.f, 0.f, 0.f}, blast = {0.f, 0.f, 0.f, 0.f};
#pragma unroll
        for (int sg = 0; sg < 8; ++sg) { const f32x4 tv = *(const LAS f32x4*)(tot + sg * 256 + t4); blast = blast + tv; if (sg < cseg) pre = pre + tv; }
        if (cseg == 0) { f32x4 d; d[0] = __expf(blast[0]); d[1] = __expf(blast[1]); d[2] = __expf(blast[2]); d[3] = __expf(blast[3]); *(GAS f32x4*)(DEC + t4) = d; }
#pragma unroll
        for (int i = 0; i < 8; ++i) { const int c = 8 * cseg + i; const f32x4 bb = bc[i] + pre;
            const float q0 = bflo(rq[i].x), q1 = bfhi(rq[i].x), q2 = bflo(rq[i].y), q3 = bfhi(rq[i].y), k0 = bflo(rk[i].x), k1 = bfhi(rk[i].x), k2 = bflo(rk[i].y), k3 = bfhi(rk[i].y);
            v2u oq, oi, oe;
            oq.x = pk2(q0 * __expf(bb[0]), q1 * __expf(bb[1])); oq.y = pk2(q2 * __expf(bb[2]), q3 * __expf(bb[3]));
            oi.x = pk2(k0 * __expf(-bb[0]), k1 * __expf(-bb[1])); oi.y = pk2(k2 * __expf(-bb[2]), k3 * __expf(-bb[3]));
            oe.x = pk2(k0 * __expf(blast[0] - bb[0]), k1 * __expf(blast[1] - bb[1])); oe.y = pk2(k2 * __expf(blast[2] - bb[2]), k3 * __expf(blast[3] - bb[3]));
            *(LAS v2u*)(qd + c * GP + t4) = oq; *(LAS v2u*)(ki + c * GP + t4) = oi; *(LAS v2u*)(ke + c * GP + t4) = oe;
            *(GAS v2u*)(QD + c * 256 + t4) = oq; }
        __syncthreads();
#pragma unroll
        for (int rep = 0; rep < 2; ++rep) { const int tl = w + 8 * rep, mi = tl >> 2, ni = tl & 3;
            f32x4 acc = {0.f, 0.f, 0.f, 0.f};
            if (ni <= mi) {
#pragma unroll
                for (int ks = 0; ks < 8; ++ks) { const bf16x8 af = *(const LAS bf16x8*)(qd + (16 * mi + fr) * GP + 32 * ks + 8 * fq), bfr = *(const LAS bf16x8*)(ki + (16 * ni + fr) * GP + 32 * ks + 8 * fq);
                    acc = MFMA16(af, bfr, acc); } }
#pragma unroll
            for (int i = 0; i < 4; ++i) { const int c = 16 * mi + 4 * fq + i, m = 16 * ni + fr; const float v = (m <= c) ? acc[i] : 0.f;
                ATT[c * 64 + m] = (bf16)(pk2(v, 0.f) & 0xffffu); } }
#pragma unroll
        for (int i = 0; i < 4; ++i) { const int G = (tid >> 4) + 32 * i, T0 = (G & 15) * 16, cg = G >> 4, li = lane & 15;
            const LAS bf16* kp = ke + (8 * cg + (li >> 2)) * GP + T0 + 4 * (li & 3);
            const s16x4 lo = __builtin_amdgcn_ds_read_tr16_b64_v4i16((LAS s16x4*)kp), hi4 = __builtin_amdgcn_ds_read_tr16_b64_v4i16((LAS s16x4*)(kp + 4 * GP));
            const bf16x8 o = {lo[0], lo[1], lo[2], lo[3], hi4[0], hi4[1], hi4[2], hi4[3]};
            *(GAS bf16x8*)(KET + (T0 + li) * 64 + 8 * cg) = o; }
        __syncthreads();
    }
}

constexpr int SC_VP = 40;
constexpr int SC_QD = 0, SC_AT = 64 * GP * 2, SC_VT = SC_AT + 64 * 72 * 2, SC_DEC = SC_VT + 64 * SC_VP * 2, SC_BUF = SC_DEC + 1024, SC_ST = 2 * SC_BUF;
static_assert(SC_ST + 2 * 32 * GP * 2 <= RING_BYTES, "scan LDS map");
struct ScanStage { v4u q0, q1, q2, q3, at, vt, dc; };
__device__ __forceinline__ void p2b_gla_scan(Frame& F) {
    LAS unsigned char* ring = F.lds + RING_OFF;
    bf16* og = WSP(bf16, WS_OGLA);
    const int tid = F.tid, lane = F.lane, w = F.wave, ql = lane & 31, hi = lane >> 5, fr = lane & 15, fq = lane >> 4, mi = w >> 1, ni = w & 1;
    for (int pass = 0; pass < 8; ++pass) {
        if (F.tid == 0) { const unsigned q = (xb_xcc_id() + (unsigned)pass) & 7u; const unsigned tk = __hip_atomic_fetch_add((unsigned*)(F.ctl + CW_SCANQ + 64 * q), 1u, __ATOMIC_RELAXED, __HIP_MEMORY_SCOPE_AGENT);
            F.MISC[16] = (tk < 32u) ? (q * 32u + tk) : 0xffffffffu; }
        __syncthreads();
        const int it = (int)__builtin_amdgcn_readfirstlane((int)F.MISC[16]);
        __syncthreads();
        if (it < 0) continue;
        pass = -1;
        const int b = it >> 6, h = (it >> 4) & 3, sl = it & 15;
        const size_t ci0 = (size_t)(b * 4 + h) * 64;
        const bf16* QDg = WSP(bf16, WS_QD) + ci0 * 64 * 256 + (size_t)tid * 8;
        const bf16* ATg = WSP(bf16, WS_ATTG) + ci0 * 64 * 64 + (size_t)tid * 8;
        const bf16* VTg = WSP(bf16, WS_PROJ) + ((size_t)b * SEQ + ((tid & 255) >> 2)) * NIN + 2048 + h * 512 + sl * 32 + (tid & 3) * 8;
        const float* DCg = WSP(float, WS_DEC) + ci0 * 256 + (size_t)(tid & 63) * 4;
        const bf16* KET = WSP(bf16, WS_KET) + ci0 * 256 * 64 + (32 * w + ql) * 64 + 8 * hi;
        const int vlS = ((8 * hi + ((lane & 15) >> 2)) * SC_VP + 16 * ((lane >> 4) & 1) + 4 * (lane & 3)) * 2, vlC = ((8 * fq + ((lane & 15) >> 2)) * SC_VP + 16 * ni + 4 * (lane & 3)) * 2;
        const int wq = ((tid >> 5) * GP + (tid & 31) * 8) * 2;
        const int wa = SC_AT + ((tid >> 3) * 72 + (tid & 7) * 8) * 2, wv = SC_VT + (((tid & 255) >> 2) * SC_VP + (tid & 3) * 8) * 2, wd = SC_DEC + (tid & 63) * 16;
#define SC_LOAD(st, n_) do { const size_t n1_ = (size_t)(n_); st.q0 = *(const GAS v4u*)(QDg + n1_ * 16384); st.q1 = *(const GAS v4u*)(QDg + n1_ * 16384 + 4096); st.q2 = *(const GAS v4u*)(QDg + n1_ * 16384 + 8192); \
        st.q3 = *(const GAS v4u*)(QDg + n1_ * 16384 + 12288); st.at = *(const GAS v4u*)(ATg + n1_ * 4096); if (tid < 256) st.vt = *(const GAS v4u*)(VTg + n1_ * (64 * NIN)); if (tid < 64) st.dc = *(const GAS v4u*)(DCg + n1_ * 256); } while (0)
#define SC_WRITE(st, bf) do { LAS unsigned char* d_ = ring + (bf) * SC_BUF; *(LAS v4u*)(d_ + wq) = st.q0; *(LAS v4u*)(d_ + wq + 16 * GP * 2) = st.q1; *(LAS v4u*)(d_ + wq + 32 * GP * 2) = st.q2; *(LAS v4u*)(d_ + wq + 48 * GP * 2) = st.q3; \
        *(LAS v4u*)(d_ + wa) = st.at; if (tid < 256) *(LAS v4u*)(d_ + wv) = st.vt; if (tid < 64) *(LAS v4u*)(d_ + wd) = st.dc; } while (0)
#define SC_KLOAD(ke, n_) do { _Pragma("unroll") for (int s_ = 0; s_ < 4; ++s_) ke[s_] = *(const GAS bf16x8*)(KET + (size_t)(n_) * 16384 + 16 * s_); } while (0)
        f32x16 S;
#pragma unroll
        for (int r = 0; r < 16; ++r) S[r] = 0.f;
        ScanStage sgA, sgB; bf16x8 keA[4], keB[4];
        sgA.vt = (v4u){0u, 0u, 0u, 0u}; sgA.dc = sgA.vt; sgB.vt = sgA.vt; sgB.dc = sgA.vt;
        SC_LOAD(sgA, 0); SC_WRITE(sgA, 0);
        SC_LOAD(sgA, 1); SC_LOAD(sgB, 2); SC_KLOAD(keA, 0); SC_KLOAD(keB, 1);
#define SC_STEP(n_, PAR, sg, ke) do { \
            LAS bf16* st_ = (LAS bf16*)(ring + SC_ST) + (PAR) * 32 * GP; const LAS unsigned char* cb_ = ring + (PAR) * SC_BUF; \
            _Pragma("unroll") for (int g_ = 0; g_ < 4; ++g_) { v2u o_; o_.x = pk2(S[4 * g_], S[4 * g_ + 1]); o_.y = pk2(S[4 * g_ + 2], S[4 * g_ + 3]); *(LAS v2u*)(st_ + ql * GP + 32 * w + 8 * g_ + 4 * hi) = o_; } \
            RAW_BAR(); \
            { f32x4 dec_[4]; bf16x8 vB_[4]; \
              _Pragma("unroll") for (int s_ = 0; s_ < 4; ++s_) { dec_[s_] = *(const LAS f32x4*)(cb_ + SC_DEC + (32 * w + 8 * s_ + 4 * hi) * 4); \
                  const s16x4 l_ = __builtin_amdgcn_ds_read_tr16_b64_v4i16((LAS s16x4*)(cb_ + SC_VT + vlS + (16 * s_) * SC_VP * 2)), h_ = __builtin_amdgcn_ds_read_tr16_b64_v4i16((LAS s16x4*)(cb_ + SC_VT + vlS + (16 * s_ + 4) * SC_VP * 2)); \
                  vB_[s_] = (bf16x8){l_[0], l_[1], l_[2], l_[3], h_[0], h_[1], h_[2], h_[3]}; } \
              _Pragma("unroll") for (int r_ = 0; r_ < 16; ++r_) S[r_] *= dec_[r_ >> 2][r_ & 3]; \
              _Pragma("unroll") for (int s_ = 0; s_ < 4; ++s_) S = MFMA32(ke[s_], vB_[s_], S); } \
            f32x4 o_ = {0.f, 0.f, 0.f, 0.f}; \
            _Pragma("unroll") for (int ks_ = 0; ks_ < 2; ++ks_) { const bf16x8 a_ = *(const LAS bf16x8*)(cb_ + SC_AT + ((16 * mi + fr) * 72 + 32 * ks_ + 8 * fq) * 2); \
                const s16x4 l_ = __builtin_amdgcn_ds_read_tr16_b64_v4i16((LAS s16x4*)(cb_ + SC_VT + vlC + (32 * ks_) * SC_VP * 2)), h_ = __builtin_amdgcn_ds_read_tr16_b64_v4i16((LAS s16x4*)(cb_ + SC_VT + vlC + (32 * ks_ + 4) * SC_VP * 2)); \
                const bf16x8 v_ = {l_[0], l_[1], l_[2], l_[3], h_[0], h_[1], h_[2], h_[3]}; o_ = MFMA16(a_, v_, o_); } \
            _Pragma("unroll") for (int ks_ = 0; ks_ < 8; ++ks_) { const bf16x8 a_ = *(const LAS bf16x8*)(cb_ + SC_QD + ((16 * mi + fr) * GP + 32 * ks_ + 8 * fq) * 2), sb_ = *(const LAS bf16x8*)(st_ + (16 * ni + fr) * GP + 32 * ks_ + 8 * fq); o_ = MFMA16(a_, sb_, o_); } \
            if ((n_) + 1 < 64) SC_WRITE(sg, 1 - (PAR)); \
            if ((n_) + 3 < 64) SC_LOAD(sg, (n_) + 3); \
            if ((n_) + 2 < 64) SC_KLOAD(ke, (n_) + 2); \
            { bf16* op_ = og + ((size_t)b * SEQ + (n_) * 64 + 16 * mi + 4 * fq) * D + h * 512 + sl * 32 + 16 * ni + fr; \
              _Pragma("unroll") for (int i_ = 0; i_ < 4; ++i_) op_[(size_t)i_ * D] = (bf16)(pk2(o_[i_], 0.f) & 0xffffu); } \
        } while (0)
        for (int n = 0; n < 64; n += 2) { SC_STEP(n, 0, sgA, keA); SC_STEP(n + 1, 1, sgB, keB); }
#undef SC_STEP
#undef SC_LOAD
#undef SC_WRITE
#undef SC_KLOAD
        __syncthreads();
    }
}

__device__ __forceinline__ void p3_rmsgate(Frame& F) {
    const bf16* og = WSP(bf16, WS_OGLA); const bf16* proj = WSP(bf16, WS_PROJ); bf16* a3 = WSP(bf16, WS_A3); const float* gn = F.in[4];
    const int gw = blockIdx.x * NWAVES + F.wave, NGW = F.G * NWAVES, lane = F.lane;
    for (int tok = gw; tok < NTOK; tok += NGW) {
        f32x4 v[8]; float ss[4];
#pragma unroll
        for (int j = 0; j < 8; ++j) { const v2u t_ = *(const GAS v2u*)(og + (size_t)tok * D + 4 * lane + 256 * j); v[j] = (f32x4){bflo(t_.x), bfhi(t_.x), bflo(t_.y), bfhi(t_.y)}; }
#pragma unroll
        for (int hh = 0; hh < 4; ++hh) { const f32x4 a = v[2 * hh], b = v[2 * hh + 1];
            float s = (a[0] * a[0] + a[1] * a[1]) + (a[2] * a[2] + a[3] * a[3]) + (b[0] * b[0] + b[1] * b[1]) + (b[2] * b[2] + b[3] * b[3]);
            ss[hh] = 1.0f / sqrtf(wave_sum(s) * (1.0f / 512.0f) + RMS_EPS); }
#pragma unroll
        for (int j = 0; j < 8; ++j) { const int col = 4 * lane + 256 * j;
            const v2u rr = *(const GAS v2u*)(proj + (size_t)tok * NIN + 4096 + col);
            const f32x4 g = *(const GAS f32x4*)(gn + (col & 511));
            const float sc = ss[j >> 1];
            const float o0 = v[j][0] * sc * g[0] * silu1(bflo(rr.x)), o1 = v[j][1] * sc * g[1] * silu1(bfhi(rr.x)), o2 = v[j][2] * sc * g[2] * silu1(bflo(rr.y)), o3 = v[j][3] * sc * g[3] * silu1(bfhi(rr.y));
            v2u o; o.x = pk2(o0, o1); o.y = pk2(o2, o3);
            *(GAS v2u*)(a3 + (size_t)tok * D + col) = o; }
    }
}

template <bool ROUTER> __device__ __forceinline__ void ln_phase(Frame& F, const bf16* T, const float* g, const float* bb, bf16* H) {
    const int gw = blockIdx.x * NWAVES + F.wave, NGW = F.G * NWAVES, lane = F.lane;
    for (int tok = gw; tok < NTOK; tok += NGW) {
        f32x4 v[8]; float s = 0.f;
#pragma unroll
        for (int j = 0; j < 8; ++j) { const v2u tq = *(const GAS v2u*)(T + (size_t)tok * D + 4 * lane + 256 * j); v[j] = (f32x4){bflo(tq.x), bfhi(tq.x), bflo(tq.y), bfhi(tq.y)}; s += (v[j][0] + v[j][1]) + (v[j][2] + v[j][3]); }
        const float mean = wave_sum(s) * (1.0f / D); float s2 = 0.f;
#pragma unroll
        for (int j = 0; j < 8; ++j) { v[j] = v[j] - mean; s2 += (v[j][0] * v[j][0] + v[j][1] * v[j][1]) + (v[j][2] * v[j][2] + v[j][3] * v[j][3]); }
        const float rstd = 1.0f / sqrtf(wave_sum(s2) * (1.0f / D) + LN_EPS);
        float lg[8];
#pragma unroll
        for (int e = 0; e < 8; ++e) lg[e] = 0.f;
#pragma unroll
        for (int j = 0; j < 8; ++j) { const int col = 4 * lane + 256 * j;
            const f32x4 gg = *(const GAS f32x4*)(g + col), bv = *(const GAS f32x4*)(bb + col);
            const f32x4 y = v[j] * rstd * gg + bv;
            v2u o; o.x = pk2(y[0], y[1]); o.y = pk2(y[2], y[3]);
            *(GAS v2u*)(H + (size_t)tok * D + col) = o;
            if (ROUTER) { const float* wr = F.in[13] + (size_t)col * 8;
#pragma unroll
                for (int c = 0; c < 4; ++c) { const f32x4 w0 = *(const GAS f32x4*)(wr + c * 8), w1 = *(const GAS f32x4*)(wr + c * 8 + 4);
                    lg[0] += y[c] * w0[0]; lg[1] += y[c] * w0[1]; lg[2] += y[c] * w0[2]; lg[3] += y[c] * w0[3];
                    lg[4] += y[c] * w1[0]; lg[5] += y[c] * w1[1]; lg[6] += y[c] * w1[2]; lg[7] += y[c] * w1[3]; } }
        }
        if (ROUTER) {
#pragma unroll
            for (int e = 0; e < 8; ++e) lg[e] = wave_sum(lg[e]);
            int i1 = 0; float v1 = lg[0];
#pragma unroll
            for (int e = 1; e < 8; ++e) if (lg[e] > v1) { v1 = lg[e]; i1 = e; }
            int i2 = -1; float v2 = -__builtin_inff();
#pragma unroll
            for (int e = 0; e < 8; ++e) if (e != i1 && lg[e] > v2) { v2 = lg[e]; i2 = e; }
            const float g1 = 1.0f / (1.0f + __expf(v2 - v1)), g2 = 1.0f - g1;
            if (lane == 0) {
                const unsigned r1 = __hip_atomic_fetch_add((unsigned*)(F.ctl + CW_CNT + 64 * i1), 1u, __ATOMIC_RELAXED, __HIP_MEMORY_SCOPE_AGENT);
                const unsigned r2 = __hip_atomic_fetch_add((unsigned*)(F.ctl + CW_CNT + 64 * i2), 1u, __ATOMIC_RELAXED, __HIP_MEMORY_SCOPE_AGENT);
                int* list = WSP(int, WS_LIST); list[(size_t)i1 * NTOK + r1] = tok; list[(size_t)i2 * NTOK + r2] = tok;
                v4u a; a.x = (unsigned)i1; a.y = r1; a.z = (unsigned)i2; a.w = r2; v4u b2; b2.x = __float_as_uint(g1); b2.y = __float_as_uint(g2); b2.z = 0u; b2.w = 0u;
                GAS v4u* ti = (GAS v4u*)(F.ws + WS_TOKINFO) + (size_t)tok * 2; ti[0] = a; ti[1] = b2; }
        }
    }
}

__device__ __forceinline__ void router_phase(Frame& F, const bf16* H) {
    const int gw = blockIdx.x * NWAVES + F.wave, NGW = F.G * NWAVES, lane = F.lane;
    for (int tok0 = gw * 4; tok0 < NTOK; tok0 += NGW * 4) {
        float lg[4][8];
#pragma unroll
        for (int t = 0; t < 4; ++t)
#pragma unroll
            for (int e = 0; e < 8; ++e) lg[t][e] = 0.f;
#pragma unroll 2
        for (int j = 0; j < 8; ++j) { const int col = 4 * lane + 256 * j;
            v2u hq[4];
#pragma unroll
            for (int t = 0; t < 4; ++t) hq[t] = *(const GAS v2u*)(H + (size_t)(tok0 + t) * D + col);
            const float* wr = F.in[13] + (size_t)col * 8;
#pragma unroll
            for (int c = 0; c < 4; ++c) { const f32x4 w0 = *(const GAS f32x4*)(wr + c * 8), w1 = *(const GAS f32x4*)(wr + c * 8 + 4);
#pragma unroll
                for (int t = 0; t < 4; ++t) { const unsigned hw = (c < 2) ? hq[t].x : hq[t].y; const float y = (c & 1) ? bfhi(hw) : bflo(hw);
                    lg[t][0] += y * w0[0]; lg[t][1] += y * w0[1]; lg[t][2] += y * w0[2]; lg[t][3] += y * w0[3];
                    lg[t][4] += y * w1[0]; lg[t][5] += y * w1[1]; lg[t][6] += y * w1[2]; lg[t][7] += y * w1[3]; } } }
#pragma unroll
        for (int t = 0; t < 4; ++t) {
#pragma unroll
            for (int e = 0; e < 8; ++e) lg[t][e] = wave_sum(lg[t][e]);
            int i1 = 0; float v1 = lg[t][0];
#pragma unroll
            for (int e = 1; e < 8; ++e) if (lg[t][e] > v1) { v1 = lg[t][e]; i1 = e; }
            int i2 = -1; float v2 = -__builtin_inff();
#pragma unroll
            for (int e = 0; e < 8; ++e) if (e != i1 && lg[t][e] > v2) { v2 = lg[t][e]; i2 = e; }
            const float g1 = 1.0f / (1.0f + __expf(v2 - v1)), g2 = 1.0f - g1;
            const int tok = tok0 + t; unsigned r1 = 0u, r2 = 0u;
            if (lane == 0) {
                r1 = __hip_atomic_fetch_add((unsigned*)(F.ctl + CW_CNT + 64 * i1), 1u, __ATOMIC_RELAXED, __HIP_MEMORY_SCOPE_AGENT);
                r2 = __hip_atomic_fetch_add((unsigned*)(F.ctl + CW_CNT + 64 * i2), 1u, __ATOMIC_RELAXED, __HIP_MEMORY_SCOPE_AGENT);
                v4u a; a.x = (unsigned)i1; a.y = r1; a.z = (unsigned)i2; a.w = r2; v4u b2; b2.x = __float_as_uint(g1); b2.y = __float_as_uint(g2); b2.z = 0u; b2.w = 0u;
                GAS v4u* ti = (GAS v4u*)(F.ws + WS_TOKINFO) + (size_t)tok * 2; ti[0] = a; ti[1] = b2; }
            r1 = (unsigned)__builtin_amdgcn_readfirstlane((int)r1); r2 = (unsigned)__builtin_amdgcn_readfirstlane((int)r2);
            unsigned char* x1 = WSP(unsigned char, WS_XG) + ((size_t)i1 * NTOK + r1) * D; unsigned char* x2 = WSP(unsigned char, WS_XG) + ((size_t)i2 * NTOK + r2) * D;
            { const GAS v4u* hp = (const GAS v4u*)(H + (size_t)tok * D + 32 * lane); v16f a0, a1;
#pragma unroll
              for (int c = 0; c < 2; ++c) { const v4u u = hp[c], v = hp[2 + c];
                  a0[8 * c + 0] = bflo(u.x); a0[8 * c + 1] = bfhi(u.x); a0[8 * c + 2] = bflo(u.y); a0[8 * c + 3] = bfhi(u.y); a0[8 * c + 4] = bflo(u.z); a0[8 * c + 5] = bfhi(u.z); a0[8 * c + 6] = bflo(u.w); a0[8 * c + 7] = bfhi(u.w);
                  a1[8 * c + 0] = bflo(v.x); a1[8 * c + 1] = bfhi(v.x); a1[8 * c + 2] = bflo(v.y); a1[8 * c + 3] = bfhi(v.y); a1[8 * c + 4] = bflo(v.z); a1[8 * c + 5] = bfhi(v.z); a1[8 * c + 6] = bflo(v.w); a1[8 * c + 7] = bfhi(v.w); }
              v4u p0, p1; mx6_record(a0, a1, p0, p1);
              const int ro = (lane >> 2) * 128 + (lane & 3) * 16;
              *(GAS v4u*)(x1 + ro) = p0; *(GAS v4u*)(x1 + ro + 64) = p1; *(GAS v4u*)(x2 + ro) = p0; *(GAS v4u*)(x2 + ro + 64) = p1; } }
    }
}

#define LOAD_CNT(cn) do { _Pragma("unroll") for (int _e = 0; _e < 8; ++_e) cn[_e] = (int)__hip_atomic_load((unsigned*)(F.ctl + CW_CNT + 64 * _e), __ATOMIC_RELAXED, __HIP_MEMORY_SCOPE_AGENT); } while (0)

__device__ __forceinline__ void p14_gather(Frame& F) {
    int cn[8]; LOAD_CNT(cn);
    const int gw = blockIdx.x * NWAVES + F.wave, NGW = F.G * NWAVES, lane = F.lane;
    int total = 0;
#pragma unroll
    for (int e = 0; e < 8; ++e) total += (cn[e] + 255) >> 8;
    const bf16* h3 = WSP(bf16, WS_H3); unsigned char* xg = WSP(unsigned char, WS_XG); const int* list = WSP(int, WS_LIST);
    for (int p = gw; p < total * 256; p += NGW) {
        int e = 0, off = 0, cnt = 0, acc = 0; bool found = false;
#pragma unroll
        for (int k = 0; k < 8; ++k) { const int te = ((cn[k] + 255) >> 8) * 256; if (!found && p < acc + te) { found = true; e = k; off = acc; cnt = cn[k]; } acc += te; }
        const int r = p - off;
        GAS v4u* dst = (GAS v4u*)(xg + (size_t)p * D) + lane;
        if (r < cnt) { const int tok = list[(size_t)e * NTOK + r]; const GAS v4u* src = (const GAS v4u*)(h3 + (size_t)tok * D) + 2 * lane;
#pragma unroll
            for (int j = 0; j < 2; ++j) { const v4u a = src[128 * j], b2 = src[128 * j + 1]; v4u o;
                o.x = pk4f8(bflo(a.x) * XSC, bfhi(a.x) * XSC, bflo(a.y) * XSC, bfhi(a.y) * XSC); o.y = pk4f8(bflo(a.z) * XSC, bfhi(a.z) * XSC, bflo(a.w) * XSC, bfhi(a.w) * XSC);
                o.z = pk4f8(bflo(b2.x) * XSC, bfhi(b2.x) * XSC, bflo(b2.y) * XSC, bfhi(b2.y) * XSC); o.w = pk4f8(bflo(b2.z) * XSC, bfhi(b2.z) * XSC, bflo(b2.w) * XSC, bfhi(b2.w) * XSC);
                dst[64 * j] = o; } }
        else { const v4u zz = {0u, 0u, 0u, 0u};
#pragma unroll
            for (int j = 0; j < 2; ++j) dst[64 * j] = zz; }
    }
}

__device__ __forceinline__ int build_moe_table(Frame& F, int NT, int wgm, bool sparse_a) {
    int cn[8]; LOAD_CNT(cn);
    int U = 0;
#pragma unroll
    for (int e = 0; e < 8; ++e) U += ((cn[e] + 255) >> 8) * NT;
    LAS int* tab = (LAS int*)(F.lds + TAB_OFF);
    const int c = blockIdx.x, G = F.G;
    if (F.tid < 64) { const long L = (long)F.tid * G + c;
        if (L < U) { int wgid = (int)L; { const int q = U / 8, r = U % 8, xcd = wgid % 8, off = wgid / 8; wgid = (xcd < r ? xcd * (q + 1) : r * (q + 1) + (xcd - r) * q) + off; }
            int e = 0, tb = 0, tiles = 1, rem = wgid, tp = 0; bool found = false;
#pragma unroll
            for (int k = 0; k < 8; ++k) { const int te = (cn[k] + 255) >> 8, ue = te * NT; if (!found) { if (rem < ue) { found = true; e = k; tiles = te; tb = tp; } else { rem -= ue; tp += te; } } }
            const int nig = wgm * NT, gid = rem / nig, fm = gid * wgm, gsz = (tiles - fm) < wgm ? (tiles - fm) : wgm;
            const int lt = fm + ((rem % nig) % gsz); tab[3 * F.tid] = sparse_a ? e * (NTOK / 256) + lt : tb + lt; tab[3 * F.tid + 1] = e * NT + (rem % nig) / gsz; tab[3 * F.tid + 2] = tb + lt; } }
    __syncthreads();
    return (U > c) ? (U - c + G - 1) / G : 0;
}

__device__ __forceinline__ void p17_final(Frame& F) {
    int cn[8]; LOAD_CNT(cn);
    const int gw = blockIdx.x * NWAVES + F.wave, NGW = F.G * NWAVES, lane = F.lane;
    const bf16* h3 = WSP(bf16, WS_H3); const unsigned char* Y = WSP(unsigned char, WS_Y); const float* g = F.in[16] + D; const float* bb = F.in[17] + D; float* out = F.out;
    for (int tok = gw; tok < NTOK; tok += NGW) {
        const GAS v4u* ti = (const GAS v4u*)(F.ws + WS_TOKINFO) + (size_t)tok * 2; const v4u a = ti[0], b2 = ti[1];
        int o1 = 0, o2 = 0, acc = 0;
#pragma unroll
        for (int k = 0; k < 8; ++k) { if ((int)a.x == k) o1 = acc; if ((int)a.z == k) o2 = acc; acc += ((cn[k] + 255) >> 8) * 256; }
        const size_t p1 = (size_t)(o1 + (int)a.y), p2 = (size_t)(o2 + (int)a.w); const float g1 = __uint_as_float(b2.x) * (1.0f / YSC), g2 = __uint_as_float(b2.y) * (1.0f / YSC);
        f32x4 v[8]; float s = 0.f;
#pragma unroll
        for (int j = 0; j < 8; ++j) { const int col = 4 * lane + 256 * j;
            const v2u hh = *(const GAS v2u*)(h3 + (size_t)tok * D + col); const int y1 = *(const GAS int*)(Y + p1 * D + col), y2 = *(const GAS int*)(Y + p2 * D + col);
            const auto a01 = __builtin_amdgcn_cvt_pk_f32_fp8(y1, false), a23 = __builtin_amdgcn_cvt_pk_f32_fp8(y1, true), b01 = __builtin_amdgcn_cvt_pk_f32_fp8(y2, false), b23 = __builtin_amdgcn_cvt_pk_f32_fp8(y2, true);
            v[j][0] = ALPHA * bflo(hh.x) + g1 * a01[0] + g2 * b01[0]; v[j][1] = ALPHA * bfhi(hh.x) + g1 * a01[1] + g2 * b01[1];
            v[j][2] = ALPHA * bflo(hh.y) + g1 * a23[0] + g2 * b23[0]; v[j][3] = ALPHA * bfhi(hh.y) + g1 * a23[1] + g2 * b23[1];
            s += (v[j][0] + v[j][1]) + (v[j][2] + v[j][3]); }
        const float mean = wave_sum(s) * (1.0f / D); float s2 = 0.f;
#pragma unroll
        for (int j = 0; j < 8; ++j) { v[j] = v[j] - mean; s2 += (v[j][0] * v[j][0] + v[j][1] * v[j][1]) + (v[j][2] * v[j][2] + v[j][3] * v[j][3]); }
        const float rstd = 1.0f / sqrtf(wave_sum(s2) * (1.0f / D) + LN_EPS);
#pragma unroll
        for (int j = 0; j < 8; ++j) { const int col = 4 * lane + 256 * j;
            const f32x4 gg = *(const GAS f32x4*)(g + col), bv = *(const GAS f32x4*)(bb + col);
            *(GAS f32x4*)(out + (size_t)tok * D + col) = v[j] * rstd * gg + bv; }
    }
}

__device__ __forceinline__ unsigned f8byte(float x) { return (unsigned)__builtin_amdgcn_cvt_pk_fp8_f32(x, x, 0, false) & 0xffu; }
__device__ __forceinline__ void p10_kmean(Frame& F) {
    LAS float* red = (LAS float*)(F.lds + RING_OFF);
    const bf16* kvq = WSP(bf16, WS_KVQ); float* km = WSP(float, WS_KM);
    const int d = F.tid & 127, q4 = F.tid >> 7;
    for (int it = blockIdx.x; it < NB * MKV * NBLK; it += F.G) {
        const int b = it >> 6, g = (it >> 4) & 3, j = it & 15;
        const bf16* base = kvq + ((size_t)b * SEQ + j * 256 + q4 * 64) * NKVQ + g * 128 + d; float s = 0.f;
        unsigned char* k8 = WSP(unsigned char, WS_K8) + (((size_t)(b * 4 + g) * SEQ + j * 256 + q4 * 64) * 128) + d;
#pragma unroll 8
        for (int r = 0; r < 64; ++r) { const float kv = bf1(base[(size_t)r * NKVQ]); s += kv; k8[r * 128] = (unsigned char)f8byte(kv); }
        v4u vo[4];
#pragma unroll
        for (int c = 0; c < 4; ++c) { unsigned w4[4];
#pragma unroll
            for (int m = 0; m < 4; ++m) { float x[4];
#pragma unroll
                for (int e = 0; e < 4; ++e) { const int sl = 16 * c + 4 * m + e, hi = sl >> 5, jj = sl & 31, r = jj & 15, key = (jj >> 4) * 32 + (r & 3) + 8 * (r >> 2) + 4 * hi;
                    x[e] = bf1(base[(size_t)key * NKVQ + 512]); }
                w4[m] = pk4f8(x[0], x[1], x[2], x[3]); }
            vo[c] = (v4u){w4[0], w4[1], w4[2], w4[3]}; }
        GAS v4u* v8 = (GAS v4u*)(WSP(unsigned char, WS_V8T) + ((((size_t)(b * 4 + g) * 64 + j * 4 + q4) * 128 + d) * 64));
#pragma unroll
        for (int c = 0; c < 4; ++c) v8[c] = vo[c];
        red[q4 * 128 + d] = s;
        __syncthreads();
        if (F.tid < 128) km[(size_t)it * 128 + d] = (red[d] + red[128 + d] + red[256 + d] + red[384 + d]) * (1.0f / 256.0f);
        __syncthreads();
    }
}
#ifndef WGM_P1
#define WGM_P1 4
#endif
#ifndef WGM_N8
#define WGM_N8 4
#endif
#ifndef WGM_GU
#define WGM_GU 4
#endif
#ifndef WGM_DD
#define WGM_DD 4
#endif
#ifndef WGM_KVQ
#define WGM_KVQ 4
#endif
#ifndef WGM_MGU
#define WGM_MGU 8
#endif
#ifndef WGM_MDN
#define WGM_MDN 8
#endif
#ifndef REPMASK
#define REPMASK 0u
#endif

constexpr float AT_THR = 3.0f;
__device__ __forceinline__ float max3f(float a, float b, float c) { float r; asm("v_max3_f32 %0, %1, %2, %3" : "=v"(r) : "v"(a), "v"(b), "v"(c)); return r; }
typedef int v8i __attribute__((ext_vector_type(8)));
#define MFMA8(a, b, c, sa, sb) __builtin_amdgcn_mfma_scale_f32_32x32x64_f8f6f4((a), (b), (c), 0, 0, 0, (sa), 0, (sb))
constexpr int A8_KP = 144, A8_VP = 80, A8_KSZ = 64 * A8_KP, A8_VSZ = 128 * A8_VP, A8_GATE = 2 * A8_KSZ + 2 * A8_VSZ, AT_GP = 136;
constexpr int CV_ITEMS = NE * (D / 64) * (2 * FE / 32), CV_LDS = 49152;
__device__ __forceinline__ void cv_issue(const Frame& F, int r, LAS unsigned char* img, int lane, int h) {
    const int r2 = r >> 1, e = r2 / 7168, rr = r2 % 7168, kb64 = 2 * (rr / 448) + (r & 1), nb = rr % 448, pn = nb >> 3, qn = nb & 7, half = qn >> 2, cg = qn & 3;
    const GAS char* src = (const GAS char*)(F.in[14] + (size_t)e * D * 2 * FE + (size_t)(64 * kb64) * (2 * FE) + half * FE + pn * 128 + cg * 32);
    const unsigned lo = (unsigned)(((lane >> 3) * (2 * FE) + 4 * (lane & 7)) * 4);
    const GAS char* p = src + lo + (size_t)h * 32 * (2 * FE) * 4;
    img += h * 4096;
#pragma unroll
    for (int i = 0; i < 4; ++i) { __builtin_amdgcn_global_load_lds((const unsigned*)p, (LAS unsigned*)(img + i * 1024), 16, 0, 0); p += (size_t)8 * (2 * FE) * 4; asm volatile("" : "+v"(p)); }
}
__device__ __forceinline__ void cv_finish(const Frame& F, int r, const LAS unsigned char* img, int lane) {
    const int r2 = r >> 1, e = r2 / 7168, rr = r2 % 7168, kb64 = 2 * (rr / 448) + (r & 1), nb = rr % 448;
    const int n = lane & 31, q = lane >> 5;
    const LAS float* s = (const LAS float*)img + (32 * q) * 32 + n;
    v16f x0, x1;
#pragma unroll
    for (int i = 0; i < 16; ++i) { x0[i] = s[i * 32]; x1[i] = s[(16 + i) * 32]; }
    v4u p0, p1; mx6_record(x0, x1, p0, p1);
    unsigned char* o = F.ws + WS_W_GUM + ((size_t)e * 2 * FE + 32 * nb + n) * (size_t)D + 128 * (kb64 >> 1) + 32 * (kb64 & 1) + 16 * q;
    *(GAS v4u*)o = p0; *(GAS v4u*)(o + 64) = p1;
}
__device__ __forceinline__ void p11_attn(Frame& F, int it0, int it1) {
    LAS unsigned char* base = F.lds + RING_OFF;
    const bf16* kvq = WSP(bf16, WS_KVQ); const float* km = WSP(float, WS_KM);
    const int tid = F.tid, lane = F.lane, w = F.wave, ql = lane & 31, hi = lane >> 5;
    const int kwoff = (tid >> 3) * A8_KP + (tid & 7) * 16, vwoff = (tid >> 2) * A8_VP + (tid & 3) * 16;
    const int kroff = ql * A8_KP + 32 * hi, vroff = ql * A8_VP + 32 * hi;
    const float NEG = -__builtin_inff();
    constexpr float L2E = 1.4426950408889634f;
    constexpr int SC1 = 0x7F7F7F7F, SC16 = 0x7B7B7B7B;
    LAS unsigned char* const cvimg = base + CV_LDS + __builtin_amdgcn_readfirstlane(w) * 8192;
    const int cvgw = (int)blockIdx.x * NWAVES + __builtin_amdgcn_readfirstlane(w), cvstep = F.G * NWAVES;
    int cvr = 2 * cvgw, cvp = -1, cvc = 0;
    const int cvpar = __builtin_amdgcn_readfirstlane(w) >> 2;
    int cvr0 = 2 * (int)blockIdx.x * NWAVES, cvp0 = -1, cvr4 = 2 * ((int)blockIdx.x * NWAVES + 4), cvp4 = -1;
#define CV_ADV(x) (((x) & 1) ? (x) - 1 + 2 * cvstep : (x) + 1)
#define CV_WAIT() do { if (cvp >= 0 && (cvc & 1) == cvpar) asm volatile("s_waitcnt vmcnt(0)" ::: "memory"); } while (0)
#define CV_HOOK() do { if ((cvc & 1) == cvpar) { if (cvp >= 0) { cv_finish(F, cvp, cvimg, lane); asm volatile("s_waitcnt lgkmcnt(0)" ::: "memory"); cvp = -1; } \
            if (cvr < CV_ITEMS) { cv_issue(F, cvr, cvimg, lane, 0); cv_issue(F, cvr, cvimg, lane, 1); cvp = cvr; cvr = CV_ADV(cvr); } } \
        if ((cvc & 1) == 0) { cvp0 = -1; if (cvr0 < CV_ITEMS) { cvp0 = cvr0; cvr0 = CV_ADV(cvr0); } } else { cvp4 = -1; if (cvr4 < CV_ITEMS) { cvp4 = cvr4; cvr4 = CV_ADV(cvr4); } } \
        ++cvc; } while (0)
    for (int id0 = blockIdx.x + it0 * F.G; id0 < NB * MH * NBLK && id0 < (int)blockIdx.x + it1 * F.G; id0 += F.G) {
        const int id = (F.G == 256) ? ((id0 & ~255) | ((id0 & 7) << 5) | ((id0 & 255) >> 3)) : id0;
        const int rr = id >> 8, q4 = (id >> 6) & 3, bh = id & 63;
        const int n = rr == 0 ? q4 : rr == 1 ? 7 - q4 : rr == 2 ? 8 + q4 : 15 - q4;
        const int b = bh >> 4, h = bh & 15, g = h >> 2;
        const size_t qrow0 = (size_t)b * SEQ + n * 256 + w * 32;
        int lo_ = (int)__builtin_amdgcn_mbcnt_hi(~0u, __builtin_amdgcn_mbcnt_lo(~0u, 0u)), to_ = __builtin_amdgcn_readfirstlane(w) * 64 + lo_; asm volatile("" : "+v"(lo_), "+v"(to_));
        const int skey = to_ >> 4, sdc = (to_ & 15) * 8;
        const unsigned qoff = (unsigned)((lo_ & 31) * NKVQ + (lo_ >> 5) * 8) * 2u, kmoff = (unsigned)((to_ >> 4) * 128 + (to_ & 15) * 8) * 4u;
        const GAS char* qb = (const GAS char*)(kvq + qrow0 * NKVQ + 1024 + h * 128);
        unsigned mask = 0u;
        { bf16x8 qf[8];
#pragma unroll
          for (int st = 0; st < 8; ++st) qf[st] = *(const GAS bf16x8*)(qb + qoff + st * 32);
          { v4u o = {0u, 0u, 0u, 0u};
            if (skey < 16) { const GAS char* kp = (const GAS char*)(km + (size_t)(b * 4 + g) * 16 * 128) + kmoff; const f32x4 a = *(const GAS f32x4*)kp, c = *(const GAS f32x4*)(kp + 16);
                o.x = pk2(a[0], a[1]); o.y = pk2(a[2], a[3]); o.z = pk2(c[0], c[1]); o.w = pk2(c[2], c[3]); }
            *(LAS v4u*)((LAS bf16*)(base + A8_GATE) + skey * AT_GP + sdc) = o; }
          __syncthreads();
          f32x16 s;
#pragma unroll
          for (int r = 0; r < 16; ++r) s[r] = 0.f;
#pragma unroll
          for (int st = 0; st < 8; ++st) { const bf16x8 kf = *(const LAS bf16x8*)((LAS bf16*)(base + A8_GATE) + ql * AT_GP + st * 16 + hi * 8); s = MFMA32(kf, qf[st], s); }
          float sc[16];
#pragma unroll
          for (int jj = 0; jj < 16; ++jj) { const int a = jj >> 3, c = (jj >> 2) & 1, i = jj & 3; const float own = s[4 * a + i]; const float oth = __shfl_xor(own, 32);
              sc[jj] = (hi == c) ? own : oth; if (jj >= n) sc[jj] = NEG; }
#pragma unroll
          for (int j = 0; j < 16; ++j) { int cnt = 0;
#pragma unroll
              for (int j2 = 0; j2 < 16; ++j2) if (j2 != j) cnt += ((sc[j2] > sc[j]) || (sc[j2] == sc[j] && j2 < j)) ? 1 : 0;
              if (cnt < 3 && j < n) mask |= (1u << j); } }
        v8i q8[2];
#pragma unroll
        for (int st = 0; st < 2; ++st) { const GAS char* qp = (const GAS char*)(kvq + qrow0 * NKVQ + 1024 + h * 128) + (unsigned)((lo_ & 31) * NKVQ + 64 * st + 32 * (lo_ >> 5)) * 2u;
#pragma unroll
            for (int c = 0; c < 4; ++c) { const v4u x = *(const GAS v4u*)(qp + 16 * c);
                q8[st][2 * c] = (int)pk4f8(bflo(x.x) * 16.f, bfhi(x.x) * 16.f, bflo(x.y) * 16.f, bfhi(x.y) * 16.f); q8[st][2 * c + 1] = (int)pk4f8(bflo(x.z) * 16.f, bfhi(x.z) * 16.f, bflo(x.w) * 16.f, bfhi(x.w) * 16.f); } }
        float m_run = -1e30f, l_run = 0.f; f32x16 o[4];
#pragma unroll
        for (int dt = 0; dt < 4; ++dt)
#pragma unroll
            for (int r = 0; r < 16; ++r) o[dt][r] = 0.f;
        const int NP = 4 * n;
        const GAS char* k8b = (const GAS char*)(WSP(unsigned char, WS_K8) + (size_t)(b * 4 + g) * SEQ * 128) + (unsigned)to_ * 16u;
        const GAS char* v8b = (const GAS char*)(WSP(unsigned char, WS_V8T) + (size_t)(b * 4 + g) * 64 * 8192) + (unsigned)to_ * 16u;
        v4u rk, rv;
        LAS unsigned char* const kring = base; LAS unsigned char* const vring = base + 2 * A8_KSZ;
#define AT_LOADK(tt) do { rk = *(const GAS v4u*)(k8b + (size_t)(tt) * 8192); } while (0)
#define AT_LOADV(tt) do { rv = *(const GAS v4u*)(v8b + (size_t)(tt) * 8192); } while (0)
#define AT_WRITEK(bf) do { *(LAS v4u*)(kring + (bf) * A8_KSZ + kwoff) = rk; } while (0)
#define AT_WRITEV(bf) do { *(LAS v4u*)(vring + (bf) * A8_VSZ + vwoff) = rv; } while (0)
#define AT_QK(bf, S0, S1) do { const LAS unsigned char* kp_ = kring + (bf) * A8_KSZ + kroff; \
            _Pragma("unroll") for (int r_ = 0; r_ < 16; ++r_) { S0[r_] = 0.f; S1[r_] = 0.f; } \
            _Pragma("unroll") for (int st_ = 0; st_ < 2; ++st_) { \
                const v4u a0_ = *(const LAS v4u*)(kp_ + 64 * st_), a1_ = *(const LAS v4u*)(kp_ + 64 * st_ + 16), b0_ = *(const LAS v4u*)(kp_ + 32 * A8_KP + 64 * st_), b1_ = *(const LAS v4u*)(kp_ + 32 * A8_KP + 64 * st_ + 16); \
                const v8i ka_ = {(int)a0_.x, (int)a0_.y, (int)a0_.z, (int)a0_.w, (int)a1_.x, (int)a1_.y, (int)a1_.z, (int)a1_.w}, kb_ = {(int)b0_.x, (int)b0_.y, (int)b0_.z, (int)b0_.w, (int)b1_.x, (int)b1_.y, (int)b1_.z, (int)b1_.w}; \
                S0 = MFMA8(ka_, q8[st_], S0, SC1, SC16); S1 = MFMA8(kb_, q8[st_], S1, SC1, SC16); } } while (0)
#define AT_SMPV(S0, S1, ROWOK, VB) do { \
            float mxa_ = max3f(S0[0], S0[1], S0[2]), mxb_ = max3f(S1[0], S1[1], S1[2]); \
            _Pragma("unroll") for (int r_ = 3; r_ < 15; r_ += 2) { mxa_ = max3f(mxa_, S0[r_], S0[r_ + 1]); mxb_ = max3f(mxb_, S1[r_], S1[r_ + 1]); } \
            float mx_ = max3f(mxa_, mxb_, S0[15]); mx_ = max3f(mx_, S1[15], S1[15]); \
            { const float o_ = __shfl_xor(mx_, 32); mx_ = max3f(mx_, o_, o_); } \
            const bool upd_ = (ROWOK) && (mx_ > m_run + AT_THR); \
            if (__any(upd_ ? 1 : 0)) { const float mn_ = upd_ ? mx_ : m_run, al_ = __builtin_amdgcn_exp2f((m_run - mn_) * L2E); l_run *= al_; m_run = mn_; \
                _Pragma("unroll") for (int dt_ = 0; dt_ < 4; ++dt_) o[dt_] = o[dt_] * al_; } \
            const float mb_ = (ROWOK) ? 4.0f - m_run * L2E : NEG;     \
            S0 = S0 * L2E + mb_; S1 = S1 * L2E + mb_; \
            _Pragma("unroll") for (int r_ = 0; r_ < 16; ++r_) { S0[r_] = __builtin_amdgcn_exp2f(S0[r_]); S1[r_] = __builtin_amdgcn_exp2f(S1[r_]); } \
            { const f32x16 t_ = S0 + S1; const float ps_ = ((t_[0] + t_[1]) + (t_[2] + t_[3])) + ((t_[4] + t_[5]) + (t_[6] + t_[7])) + ((t_[8] + t_[9]) + (t_[10] + t_[11])) + ((t_[12] + t_[13]) + (t_[14] + t_[15])); \
              l_run += ps_; } \
            v8i pf_; \
            _Pragma("unroll") for (int m_ = 0; m_ < 4; ++m_) { pf_[m_] = (int)pk4f8(S0[4 * m_], S0[4 * m_ + 1], S0[4 * m_ + 2], S0[4 * m_ + 3]); \
                pf_[4 + m_] = (int)pk4f8(S1[4 * m_], S1[4 * m_ + 1], S1[4 * m_ + 2], S1[4 * m_ + 3]); } \
            const LAS unsigned char* vb_ = (VB) + vroff; \
            _Pragma("unroll") for (int dt_ = 0; dt_ < 4; ++dt_) { const v4u a0_ = *(const LAS v4u*)(vb_ + 32 * dt_ * A8_VP), a1_ = *(const LAS v4u*)(vb_ + 32 * dt_ * A8_VP + 16); \
                const v8i va_ = {(int)a0_.x, (int)a0_.y, (int)a0_.z, (int)a0_.w, (int)a1_.x, (int)a1_.y, (int)a1_.z, (int)a1_.w}; \
                o[dt_] = MFMA8(va_, pf_, o[dt_], SC1, SC16); } } while (0)
        __syncthreads();
        if (NP > 0) {
            AT_LOADK(0); AT_LOADV(0); AT_WRITEK(0); AT_WRITEV(0);
            AT_LOADK(1); AT_WRITEK(1);
            RAW_BAR();
            f32x16 c0, c1, n0, n1;
            AT_QK(0, c0, c1);
            AT_LOADK(2); AT_LOADV(1);
            RAW_BAR();
#define AT_STEP(tt_, C0, C1, N0, N1) do { const bool ok_ = ((mask >> ((tt_) >> 2)) & 1u) != 0u; \
                AT_QK(((tt_) + 1) & 1, N0, N1); \
                AT_SMPV(C0, C1, ok_, vring + ((tt_) & 1) * A8_VSZ); \
                AT_WRITEK((tt_) & 1); AT_WRITEV(((tt_) + 1) & 1); \
                CV_WAIT(); \
                { const int tk_ = ((tt_) + 3 < NP) ? (tt_) + 3 : NP - 1, tv_ = ((tt_) + 2 < NP) ? (tt_) + 2 : NP - 1; AT_LOADK(tk_); AT_LOADV(tv_); } \
                RAW_BAR(); \
                __builtin_amdgcn_sched_barrier(0); CV_HOOK(); __builtin_amdgcn_sched_barrier(0); } while (0)
            for (int tt = 0; tt < NP; tt += 2) { AT_STEP(tt, c0, c1, n0, n1); AT_STEP(tt + 1, n0, n1, c0, c1); }
#undef AT_STEP
        }
        { AT_LOADK(NP); AT_LOADV(NP); AT_WRITEK(0); AT_WRITEV(0); AT_LOADK(NP + 1); AT_LOADV(NP + 1);
          RAW_BAR();
          for (int kt = 0; kt < 4; ++kt) {
              if (kt <= (w >> 1)) {
                  f32x16 s0, s1; AT_QK(kt & 1, s0, s1);
                  if (kt == (w >> 1)) { const int qpos = 32 * w + ql - 64 * kt;
#pragma unroll
                      for (int r = 0; r < 16; ++r) { const int key = (r & 3) + 8 * (r >> 2) + 4 * hi; if (key > qpos) s0[r] = NEG; if (key + 32 > qpos) s1[r] = NEG; } }
                  AT_SMPV(s0, s1, true, vring + (kt & 1) * A8_VSZ);
              }
              if (kt + 1 < 4) { AT_WRITEK((kt + 1) & 1); AT_WRITEV((kt + 1) & 1); }
              if (kt + 2 < 4) { AT_LOADK(NP + kt + 2); AT_LOADV(NP + kt + 2); }
              RAW_BAR();
          } }
#undef AT_LOADK
#undef AT_LOADV
#undef AT_WRITEK
#undef AT_WRITEV
#undef AT_QK
#undef AT_SMPV
        int lo2_ = (int)__builtin_amdgcn_mbcnt_hi(~0u, __builtin_amdgcn_mbcnt_lo(~0u, 0u)); asm volatile("" : "+v"(lo2_));
        const unsigned ooff = (unsigned)((lo2_ & 31) * D + 4 * (lo2_ >> 5)) * 2u;
        const float lt = l_run + __shfl_xor(l_run, 32), inv = 16.0f * OSC / lt;
        unsigned char* a8 = WSP(unsigned char, WS_A3) + qrow0 * D + h * 128;
#pragma unroll
        for (int dt = 0; dt < 4; ++dt)
#pragma unroll
            for (int g4 = 0; g4 < 4; ++g4) *(GAS unsigned*)(a8 + (ooff >> 1) + dt * 32 + 8 * g4) = pk4f8(o[dt][4 * g4] * inv, o[dt][4 * g4 + 1] * inv, o[dt][4 * g4 + 2] * inv, o[dt][4 * g4 + 3] * inv);
    }
    while (cvp0 >= 0 || cvr0 < CV_ITEMS || cvp4 >= 0 || cvr4 < CV_ITEMS) { CV_WAIT(); RAW_BAR(); CV_HOOK(); }
#undef CV_HOOK
#undef CV_WAIT
#undef CV_ADV
}

struct Args { const float* in[18]; float* out; unsigned char* ws; int ph_lo, ph_hi; };
__global__ void __launch_bounds__(NWAVES * 64, 2) mk_fwd(Args args) {
    extern __shared__ __attribute__((aligned(16))) unsigned char lds[];
    Frame F;
    F.lds = (LAS unsigned char*)lds;
    F.MISC = (volatile LAS unsigned*)(F.lds + MISC_OFF);
    F.tid = threadIdx.x; F.lane = F.tid & 63; F.wave = __builtin_amdgcn_readfirstlane(F.tid >> 6);
    F.G = gridDim.x; F.ws = args.ws; F.out = args.out;
#pragma unroll
    for (int i = 0; i < 18; ++i) F.in[i] = args.in[i];
    F.ctl = (gu32*)(args.ws + WS_CTL);
    for (int u = F.tid; u < (LDS_BYTES - LDSCTL_OFF) / 4; u += NWAVES * 64) ((LAS unsigned*)(F.lds + LDSCTL_OFF))[u] = 0u;
    __syncthreads();
    XcdBarrier bar; bar.bar = (unsigned*)(F.ctl + CW_BAR); bar.x = 0; bar.st = nullptr;
    if (MK_ONE_LAUNCH) bar = xcd_barrier_post((unsigned*)(F.ctl + CW_BAR), F.MISC + 8);
    const int lo = args.ph_lo, hi = args.ph_hi;
#define IN(k) (lo <= (k) && (k) < hi)
#define SEAM(k) do { if (IN(k) && IN((k) + 1)) { xcd_barrier(bar); if (REPMASK & 0x80000000u) { xcd_barrier(bar); xcd_barrier(bar); } } } while (0)
    if (F.tid == 0) { const unsigned xcc = xb_xcc_id(); const unsigned rk = __hip_atomic_fetch_add((unsigned*)(F.ctl + CW_XRANK + 64 * (xcc & 7u)), 1u, __ATOMIC_RELAXED, __HIP_MEMORY_SCOPE_AGENT); F.MISC[20] = rk * 8u + (xcc & 7u); }
    int bx = (int)blockIdx.x;

#define PHASE(k, ...) do { if (IN(k)) { __VA_ARGS__ if ((REPMASK >> (k)) & 1u) { __syncthreads(); __VA_ARGS__ } } SEAM(k); } while (0)
    PHASE(0, p0_prologue<0>(F););
    if (IN(0) && IN(1) && F.G == 256) { bool ok = true;
#pragma unroll
        for (int j = 0; j < 8; ++j) ok = ok && (__hip_atomic_load((unsigned*)(F.ctl + CW_XRANK + 64 * j), __ATOMIC_RELAXED, __HIP_MEMORY_SCOPE_AGENT) == 32u);
        if (ok) bx = (int)__builtin_amdgcn_readfirstlane((int)F.MISC[20]); }
    PHASE(1,
        { pg8::Gemm g{WSP(pg8::bf16_t, WS_XB), WSP(pg8::bf16_t, WS_W_IN), NTOK, NIN, D}; pg8::StaticOrder S; S.init(NTOK, NIN, F.G, bx, WGM_P1);
        pg8::EpiBf16Plain E{WSP(pg8::bf16_t, WS_PROJ), NIN, NIN / 256, 1.0f};
        pg8::gemm_phase<pg8::EpiBf16Plain, pg8::StaticOrder, PG8_ALIGN, PG8_SP2>(F.lds + RING_OFF, g, S, E);
        p1_gate(F); if (REPMASK & 0x40000000u) p1_gate(F); });
    PHASE(2, p2a_gla_pre(F););
    PHASE(3, p2b_gla_scan(F););
    PHASE(4, p3_rmsgate(F););
    PHASE(5,
        { pg8::Gemm g{WSP(pg8::bf16_t, WS_A3), WSP(pg8::bf16_t, WS_W_OA), NTOK, D, D}; pg8::StaticOrder S; S.init(NTOK, D, F.G, bx, WGM_N8);
        pg8::EpiLnFused<false> E{WSP(pg8::bf16_t, WS_H1), (const void*)F.in[0], D, ALPHA, F.in[9], F.in[10], WSP(unsigned long long, WS_SLOTS), (unsigned*)(F.ctl + CW_PANEL), (unsigned*)(F.ctl + CW_TMO), F.lds + LNTAB_OFF};
        pg8::gemm_phase<pg8::EpiLnFused<false>, pg8::StaticOrder, true, PG8_SP2>(F.lds + RING_OFF, g, S, E); });
    static_assert(WGM_N8 * 8 <= 32 && WGM_DD * 8 <= 32, "fused LayerNorm epilogues: the 8 column tiles of a row panel must run in the same round (one 32-unit group per XCD round)");
    PHASE(7,
        { pg8::Gemm g{WSP(pg8::bf16_t, WS_H1), WSP(pg8::bf16_t, WS_W_GUD), NTOK, 2 * FD, D}; pg8::StaticOrder S; S.init(NTOK, 2 * FD, F.G, bx, WGM_GU);
        pg8::EpiSwiglu E{WSP(pg8::bf16_t, WS_ACT), FD, 2 * FD / 256};
        pg8::gemm_phase<pg8::EpiSwiglu, pg8::StaticOrder, PG8_ALIGN, PG8_SP2>(F.lds + RING_OFF, g, S, E); });
    PHASE(8,
        { pg8::Gemm g{WSP(pg8::bf16_t, WS_ACT), WSP(pg8::bf16_t, WS_W_DD), NTOK, D, FD}; pg8::StaticOrder S; S.init(NTOK, D, F.G, bx, WGM_DD);
        pg8::EpiLnFused<true> E{WSP(pg8::bf16_t, WS_H2), (const void*)WSP(bf16, WS_H1), D, ALPHA, F.in[16], F.in[17], WSP(unsigned long long, WS_SLOTS) + (size_t)NTOK * 8, (unsigned*)(F.ctl + CW_PANEL + 64 * 64), (unsigned*)(F.ctl + CW_TMO), F.lds + LNTAB_OFF};
        pg8::gemm_phase<pg8::EpiLnFused<true>, pg8::StaticOrder, true, PG8_SP2>(F.lds + RING_OFF, g, S, E); });
    PHASE(10,
        { pg8::Gemm g{WSP(pg8::bf16_t, WS_H2), WSP(pg8::bf16_t, WS_W_KVQ), NTOK, NKVQ, D}; pg8::StaticOrder S; S.init(NTOK, NKVQ, F.G, bx, WGM_KVQ);
        pg8::EpiBf16Plain E{WSP(pg8::bf16_t, WS_KVQ), NKVQ, NKVQ / 256, 1.0f};
        pg8::gemm_phase<pg8::EpiBf16Plain, pg8::StaticOrder, PG8_ALIGN, PG8_SP2>(F.lds + RING_OFF, g, S, E); });
    PHASE(11, p10_kmean(F););
    PHASE(12, p11_attn(F, 0, 1 << 20););
    { int l_ = (int)__builtin_amdgcn_mbcnt_hi(~0u, __builtin_amdgcn_mbcnt_lo(~0u, 0u)); asm volatile("" : "+v"(l_)); F.lane = l_; F.tid = F.wave * 64 + l_; }
    PHASE(13,
        { pg8::Gemm g{WSP(pg8::bf16_t, WS_A3), WSP(pg8::bf16_t, WS_W_OB), NTOK, D, D / 2, 0x78787878, 0x7A7A7A7A}; pg8::StaticOrder S; S.init(NTOK, D, F.G, bx, WGM_N8);
        pg8::EpiLnFused<true> E{WSP(pg8::bf16_t, WS_H3), (const void*)WSP(bf16, WS_H2), D, ALPHA, F.in[9] + D, F.in[10] + D, WSP(unsigned long long, WS_SLOTS) + (size_t)2 * NTOK * 8, (unsigned*)(F.ctl + CW_PANEL + 2 * 64 * 64), (unsigned*)(F.ctl + CW_TMO), F.lds + LNTAB_OFF};
        pg8::gemm_phase<pg8::EpiLnFused<true>, pg8::StaticOrder, true, PG8_SP2, true>(F.lds + RING_OFF, g, S, E); });
    static_assert(((REPMASK >> 14) & 1u) == 0u, "the routing phase counts with atomics: not repeatable");
    #ifndef CONV_REP
#define CONV_REP 0
#endif
    PHASE(14, router_phase(F, WSP(bf16, WS_H3)););
    PHASE(16,
        { const int nu = build_moe_table(F, 2 * FE / 256, WGM_MGU, true);
        pg8::Gemm g{WSP(pg8::bf16_t, WS_XG), WSP(pg8::bf16_t, WS_W_GUM), NE * NTOK, NE * 2 * FE, D / 2};
        const int t0 = ((const LAS int*)(F.lds + TAB_OFF))[3 * F.lane], t1 = ((const LAS int*)(F.lds + TAB_OFF))[3 * F.lane + 1], t2 = ((const LAS int*)(F.lds + TAB_OFF))[3 * F.lane + 2];
        pg8::EpiSwigluF8 E{WSP(unsigned char, WS_ACTM), FE, 2 * FE / 256, ASC};
        int kc = 1 + 3 * ((blockIdx.x >> 3) & 7); kc = kc < nu ? kc : nu;
        { pg8::TableOrder S{t0, t1, t2, kc, 0}; pg8::gemm_phase<pg8::EpiSwigluF8, pg8::TableOrder, PG8_ALIGN, PG8_SP2, 2>(F.lds + RING_OFF, g, S, E); }
        __syncthreads(); p0_expert<2>(F); __syncthreads();
        { pg8::TableOrder S{t0, t1, t2, nu, kc}; pg8::gemm_phase<pg8::EpiSwigluF8, pg8::TableOrder, PG8_ALIGN, PG8_SP2, 2>(F.lds + RING_OFF, g, S, E); } });
    PHASE(17,
        { const int nu = build_moe_table(F, D / 256, WGM_MDN, false);
        pg8::Gemm g{WSP(pg8::bf16_t, WS_ACTM), WSP(pg8::bf16_t, WS_W_DM), XG_ROWS, NE * D, FE / 2, 0x77777777, 0x7D7D7D7D};
        pg8::TableOrder S{((const LAS int*)(F.lds + TAB_OFF))[3 * F.lane], ((const LAS int*)(F.lds + TAB_OFF))[3 * F.lane + 1], ((const LAS int*)(F.lds + TAB_OFF))[3 * F.lane + 2], nu};
        pg8::EpiF8Plain E{WSP(unsigned char, WS_Y), D, D / 256, YSC};
        pg8::gemm_phase<pg8::EpiF8Plain, pg8::TableOrder, PG8_ALIGN, PG8_SP2, true>(F.lds + RING_OFF, g, S, E); });
    PHASE(18, p17_final(F););
#undef PHASE
#undef IN
#undef SEAM
}

extern "C" void kernel_launch(void* const* d_in, const int* in_sizes, int n_in, void* d_out, int out_size, void* d_ws, size_t ws_size, hipStream_t stream) {
    static int grid = 0;
    if (grid == 0) {
        if (n_in != 18 || out_size != NTOK * D || ws_size < WS_END) { fprintf(stderr, "kernel_launch: unexpected shapes (n_in %d out %d ws %zu need %zu)\n", n_in, out_size, ws_size, (size_t)WS_END); grid = -1; return; }
        int dev = 0, cus = 0, per_cu = 0;
        if (hipGetDevice(&dev) != hipSuccess || hipDeviceGetAttribute(&cus, hipDeviceAttributeMultiprocessorCount, dev) != hipSuccess) { grid = -1; return; }
        if (hipFuncSetAttribute((const void*)mk_fwd, hipFuncAttributeMaxDynamicSharedMemorySize, LDS_BYTES) != hipSuccess) { fprintf(stderr, "kernel_launch: hipFuncSetAttribute failed\n"); grid = -1; return; }
        if (hipOccupancyMaxActiveBlocksPerMultiprocessor(&per_cu, (const void*)mk_fwd, NWAVES * 64, LDS_BYTES) != hipSuccess || per_cu < 1) { fprintf(stderr, "kernel_launch: occupancy query says %d\n", per_cu); }
        (void)hipGetLastError();
        grid = cus;
    }
    if (grid < 0) return;
    (void)hipMemsetAsync((char*)d_ws + WS_CTL, 0, CTL_ZERO_BYTES, stream);
    Args a{};
    for (int i = 0; i < 18; ++i) a.in[i] = (const float*)d_in[i];
    a.out = (float*)d_out; a.ws = (unsigned char*)d_ws;
    if (MK_ONE_LAUNCH) { a.ph_lo = 0; a.ph_hi = NPH; hipLaunchKernelGGL(mk_fwd, dim3(grid), dim3(NWAVES * 64), LDS_BYTES, stream, a); }
    else for (int p = 0; p < NPH; ++p) { a.ph_lo = p; a.ph_hi = p + 1; hipLaunchKernelGGL(mk_fwd, dim3(grid), dim3(NWAVES * 64), LDS_BYTES, stream, a); }
}
```
